# Optimizing an MI355X kernel written in HIP

```python
import jax, jax.numpy as jnp
from jax import lax
import numpy as np

D_MODEL = 1024
BATCH = 32
SEQ = 2048
DEPTH = 2

GRID_W = 64
CTX_LEN = 256
RET_HEADS = 4
RET_DK = 128
RET_DV = 128
RET_CHUNK = 128
SWA_HEADS = 8
SWA_KV_HEADS = 2
SWA_HEAD_DIM = 64
SWA_WINDOW = 128
SWA_BLOCK = 128
NA_HEADS = 16
NA_HEAD_DIM = 64
NA_ROWS = 8
NA_COLS = 16
D_FF = 2816
CONV_W = 3
ROPE_BASE = 10000.0
EPS = 1e-6
NEG_INF = -1e30
RET_Q = RET_HEADS * RET_DK
RET_V = RET_HEADS * RET_DV
SWA_Q = SWA_HEADS * SWA_HEAD_DIM
SWA_KV = SWA_KV_HEADS * SWA_HEAD_DIM
AB_SIZES = (RET_Q, RET_Q, RET_V, RET_V, SWA_Q, SWA_KV, SWA_KV)
AB_IN = 2 * RET_Q + 2 * RET_V + SWA_Q + 2 * SWA_KV
AB_MIX = RET_V + SWA_Q
NA_DIM = NA_HEADS * NA_HEAD_DIM
N_EVEN = (DEPTH + 1) // 2
N_ODD = DEPTH // 2

kernel_name = 'hybrid_retention_swa_natten_dit'


def rmsnorm(x, g):
    xf = x.astype(jnp.float32)
    y = xf * lax.rsqrt(jnp.mean(xf * xf, axis=-1, keepdims=True) + EPS)
    return (y * g.astype(jnp.float32)).astype(x.dtype)


def modulate(h, shift, scale):
    return h * (1.0 + scale) + shift


def heads(x, n):
    b, t, _ = x.shape
    return x.reshape(b, t, n, -1).transpose(0, 2, 1, 3)


def merge(x):
    b, h, t, d = x.shape
    return x.transpose(0, 2, 1, 3).reshape(b, t, h * d)


def rope_1d(x, pos):
    half = x.shape[-1] // 2
    inv_freq = ROPE_BASE ** (-jnp.arange(half, dtype=jnp.float32) / half)
    ang = pos.astype(jnp.float32)[:, None] * inv_freq[None, :]
    cos, sin = jnp.cos(ang).astype(x.dtype), jnp.sin(ang).astype(x.dtype)
    x1, x2 = x[..., :half], x[..., half:]
    return jnp.concatenate([x1 * cos - x2 * sin, x1 * sin + x2 * cos], axis=-1)


def rope_2d(x):
    t = jnp.arange(x.shape[2])
    half = x.shape[-1] // 2
    return jnp.concatenate([rope_1d(x[..., :half], t // GRID_W), rope_1d(x[..., half:], t % GRID_W)], axis=-1)


def retention_chunked(q, k, v, log_g, s0, strict):
    b, h, t, dk = q.shape
    dv = v.shape[-1]
    n = t // RET_CHUNK

    def chunks(a):
        return a.reshape(b, h, n, RET_CHUNK, a.shape[-1]).transpose(2, 0, 1, 3, 4)

    j = jnp.arange(RET_CHUNK, dtype=jnp.float32)
    diff = j[:, None] - j[None, :]
    mask = diff > 0 if strict else diff >= 0
    dmat = jnp.where(mask, jnp.exp(log_g[:, None, None] * jnp.maximum(diff, 0.0)), 0.0)
    q_dec = jnp.exp(log_g[:, None] * (j + 1.0))[..., None]
    k_dec = jnp.exp(log_g[:, None] * (RET_CHUNK - 1.0 - j))[..., None]
    c_dec = jnp.exp(log_g * RET_CHUNK)[:, None, None]

    def step(s, inp):
        qi, ki, vi = inp
        inner = jnp.einsum('bhid,bhjd->bhij', qi, ki) * dmat
        o = jnp.einsum('bhij,bhjv->bhiv', inner, vi) + jnp.einsum('bhid,bhdv->bhiv', qi * q_dec, s)
        s = s * c_dec + jnp.einsum('bhjd,bhjv->bhdv', ki * k_dec, vi)
        return s, o

    s, o = lax.scan(step, s0, (chunks(q), chunks(k), chunks(v)))
    return o.transpose(1, 2, 0, 3, 4).reshape(b, h, t, dv), s


def retention_final_state(k, v, log_g):
    t = k.shape[2]
    w = jnp.exp(log_g[:, None] * (t - 1.0 - jnp.arange(t, dtype=jnp.float32)))
    return jnp.einsum('bhtd,bhtv->bhdv', k * w[None, :, :, None], v)


def bidir_retention(qx, kx, vx, qc, kc, vc, log_g, need_ctx):
    flip = lambda a: jnp.flip(a, axis=2)
    b, h, _, dk = qx.shape
    zeros = jnp.zeros((b, h, dk, vx.shape[-1]), jnp.float32)
    oc = None
    if need_ctx:
        oc_f, s_f = retention_chunked(qc, kc, vc, log_g[0], zeros, False)
        oc_b, s_b = retention_chunked(flip(qc), flip(kc), flip(vc), log_g[1], zeros, True)
        oc = oc_f + flip(oc_b)
    else:
        s_f = retention_final_state(kc, vc, log_g[0])
        s_b = retention_final_state(flip(kc), flip(vc), log_g[1])
    ox_f, _ = retention_chunked(qx, kx, vx, log_g[0], s_f, False)
    ox_b, _ = retention_chunked(flip(qx), flip(kx), flip(vx), log_g[1], s_b, True)
    return ox_f + flip(ox_b), oc


def ret_out(y, g):
    yn = y * lax.rsqrt(jnp.mean(y * y, axis=-1, keepdims=True) + EPS)
    return merge(yn).astype(g.dtype) * jax.nn.silu(g)


def window_attention(qx, kx, vx, qc, kc, vc, sink, need_ctx):
    b, hq, s, d = qx.shape
    hkv = kx.shape[1]
    g = hq // hkv
    n_ctx = kc.shape[2]
    scale = d ** -0.5
    span = SWA_BLOCK + 2 * SWA_WINDOW
    sink_g = sink.astype(jnp.float32).reshape(1, hkv, g, 1, 1)

    def ctx_logits(q):
        s_ctx = jnp.einsum('bhgqd,bhkd->bhgqk', q, kc).astype(jnp.float32) * scale
        return s_ctx, jnp.broadcast_to(sink_g, s_ctx.shape[:-1] + (1,))

    qg = qx.reshape(b, hkv, g, s, d)
    pad = ((0, 0), (0, 0), (SWA_WINDOW, SWA_WINDOW), (0, 0))
    kp, vp = jnp.pad(kx, pad), jnp.pad(vx, pad)
    band = jnp.abs(jnp.arange(SWA_BLOCK)[:, None] - jnp.arange(span)[None, :] + SWA_WINDOW) <= SWA_WINDOW

    def block(i):
        start = i * SWA_BLOCK
        qb = lax.dynamic_slice_in_dim(qg, start, SWA_BLOCK, axis=3)
        kb = lax.dynamic_slice_in_dim(kp, start, span, axis=2)
        vb = lax.dynamic_slice_in_dim(vp, start, span, axis=2)
        kpos = start - SWA_WINDOW + jnp.arange(span)
        valid = band & ((kpos >= 0) & (kpos < s))[None, :]
        s_loc = jnp.einsum('bhgqd,bhkd->bhgqk', qb, kb).astype(jnp.float32) * scale
        s_loc = jnp.where(valid, s_loc, NEG_INF)
        s_ctx, s_sink = ctx_logits(qb)
        p = jax.nn.softmax(jnp.concatenate([s_loc, s_ctx, s_sink], axis=-1), axis=-1).astype(vx.dtype)
        return (jnp.einsum('bhgqk,bhkd->bhgqd', p[..., :span], vb)
                + jnp.einsum('bhgqk,bhkd->bhgqd', p[..., span:span + n_ctx], vc))

    ox = lax.map(block, jnp.arange(s // SWA_BLOCK))
    ox = ox.transpose(1, 2, 3, 0, 4, 5).reshape(b, hq, s, d)
    oc = None
    if need_ctx:
        qcg = qc.reshape(b, hkv, g, n_ctx, d)
        s_ctx, s_sink = ctx_logits(qcg)
        p = jax.nn.softmax(jnp.concatenate([s_ctx, s_sink], axis=-1), axis=-1).astype(vc.dtype)
        oc = jnp.einsum('bhgqk,bhkd->bhgqd', p[..., :n_ctx], vc).reshape(b, hq, n_ctx, d)
    return ox, oc


def neighbourhood_attention(qx, kx, vx, qc, kc, vc, rpb, need_ctx):
    b, h, s, d = qx.shape
    rows = s // GRID_W
    n_kr = min(NA_ROWS, rows)
    ncb = GRID_W // NA_COLS
    sw = 2 * NA_COLS
    n_ctx = kc.shape[2]
    scale = d ** -0.5
    sup = np.clip(np.arange(ncb) * NA_COLS - NA_COLS // 2, 0, GRID_W - sw)[:, None] + np.arange(sw)[None, :]
    qcol = np.arange(GRID_W).reshape(ncb, NA_COLS)
    qstart = np.clip(qcol - NA_COLS // 2, 0, GRID_W - NA_COLS)
    kcol = sup[:, None, :]
    col_valid = (kcol >= qstart[..., None]) & (kcol < qstart[..., None] + NA_COLS)
    dc = np.clip(kcol - qcol[..., None], 1 - NA_COLS, NA_COLS - 1) + NA_COLS - 1
    rpb_c = rpb.astype(jnp.float32)[:, :, dc]
    qg = qx.reshape(b, h, rows, GRID_W, d)
    kg = kx.reshape(b, h, rows, GRID_W, d)
    vg = vx.reshape(b, h, rows, GRID_W, d)

    def row(r):
        rs = jnp.clip(r - n_kr // 2, 0, rows - n_kr)
        qr = lax.dynamic_index_in_dim(qg, r, axis=2, keepdims=False).reshape(b, h, ncb, NA_COLS, d)
        kr = lax.dynamic_slice_in_dim(kg, rs, n_kr, axis=2)[:, :, :, sup]
        vr = lax.dynamic_slice_in_dim(vg, rs, n_kr, axis=2)[:, :, :, sup]
        bias = jnp.take(rpb_c, rs - r + NA_ROWS - 1 + jnp.arange(n_kr), axis=1).transpose(0, 2, 3, 1, 4)
        s_loc = jnp.einsum('bhmqd,bhrmkd->bhmqrk', qr, kr).astype(jnp.float32) * scale + bias
        s_loc = jnp.where(col_valid[:, :, None, :], s_loc, NEG_INF).reshape(b, h, ncb, NA_COLS, n_kr * sw)
        s_ctx = jnp.einsum('bhmqd,bhnd->bhmqn', qr, kc).astype(jnp.float32) * scale
        p = jax.nn.softmax(jnp.concatenate([s_loc, s_ctx], axis=-1), axis=-1).astype(vx.dtype)
        p_loc = p[..., :n_kr * sw].reshape(b, h, ncb, NA_COLS, n_kr, sw)
        o = (jnp.einsum('bhmqrk,bhrmkd->bhmqd', p_loc, vr)
             + jnp.einsum('bhmqn,bhnd->bhmqd', p[..., n_kr * sw:], vc))
        return o.reshape(b, h, GRID_W, d)

    ox = lax.map(row, jnp.arange(rows)).transpose(1, 2, 0, 3, 4).reshape(b, h, s, d)
    oc = None
    if need_ctx:
        p = jax.nn.softmax(jnp.einsum('bhqd,bhkd->bhqk', qc, kc).astype(jnp.float32) * scale, axis=-1).astype(vc.dtype)
        oc = jnp.einsum('bhqk,bhkd->bhqd', p, vc)
    return ox, oc


def mixer_ab(hx, hc, w_in, w_out, decay_exp, sink, need_ctx):
    idx = np.cumsum(AB_SIZES)[:-1].tolist()
    px = jnp.split(hx @ w_in, idx, axis=-1)
    pc = jnp.split(hc @ w_in, idx, axis=-1)
    f32 = jnp.float32
    t = jnp.arange(hx.shape[1])
    k_scale = RET_DK ** -0.5
    qa_x = rope_1d(heads(px[0], RET_HEADS), t).astype(f32)
    ka_x = rope_1d(heads(px[1], RET_HEADS), t).astype(f32) * k_scale
    va_x = heads(px[2], RET_HEADS).astype(f32)
    qa_c = heads(pc[0], RET_HEADS).astype(f32)
    ka_c = heads(pc[1], RET_HEADS).astype(f32) * k_scale
    va_c = heads(pc[2], RET_HEADS).astype(f32)
    log_g = jnp.log1p(-jnp.exp2(-decay_exp.astype(f32)))
    ya_x, ya_c = bidir_retention(qa_x, ka_x, va_x, qa_c, ka_c, va_c, log_g, need_ctx)
    qb_x = rope_2d(heads(px[4], SWA_HEADS))
    kb_x = rope_2d(heads(px[5], SWA_KV_HEADS))
    vb_x = heads(px[6], SWA_KV_HEADS)
    yb_x, yb_c = window_attention(qb_x, kb_x, vb_x, heads(pc[4], SWA_HEADS), heads(pc[5], SWA_KV_HEADS),
                                  heads(pc[6], SWA_KV_HEADS), sink, need_ctx)
    ox = jnp.concatenate([ret_out(ya_x, px[3]), merge(yb_x)], axis=-1) @ w_out
    oc = None
    if need_ctx:
        oc = jnp.concatenate([ret_out(ya_c, pc[3]), merge(yb_c)], axis=-1) @ w_out
    return ox, oc


def mixer_c(hx, hc, w_in, w_out, rpb, need_ctx):
    qx, kx, vx = (heads(a, NA_HEADS) for a in jnp.split(hx @ w_in, 3, axis=-1))
    if need_ctx:
        qc, kc, vc = (heads(a, NA_HEADS) for a in jnp.split(hc @ w_in, 3, axis=-1))
    else:
        qc = None
        kc, vc = (heads(a, NA_HEADS) for a in jnp.split(hc @ w_in[:, NA_DIM:], 2, axis=-1))
    ox, oc = neighbourhood_attention(qx, kx, vx, qc, kc, vc, rpb, need_ctx)
    return merge(ox) @ w_out, (merge(oc) @ w_out if need_ctx else None)


def conv_ffn(h, w_up, conv_w, conv_b, w_down):
    u = h @ w_up
    t = u.shape[1]
    up = jnp.pad(u, ((0, 0), (CONV_W // 2, CONV_W // 2), (0, 0)))
    u = conv_b + sum(conv_w[i] * up[:, i:i + t] for i in range(CONV_W))
    a, g = jnp.split(u, 2, axis=-1)
    return (jax.nn.silu(g) * a) @ w_down


def setup_inputs(seed: int = 0) -> dict:
    key = jax.random.key(seed)
    ks = jax.random.split(key, 20)
    f32 = jnp.float32

    def nrm(k, shape, scale):
        return jax.random.normal(k, shape, f32) * scale

    return {
        'x': nrm(ks[0], (BATCH, SEQ, D_MODEL), 1.0),
        'c': nrm(ks[1], (BATCH, D_MODEL), 1.0),
        'ctx': nrm(ks[2], (BATCH, CTX_LEN, D_MODEL), 1.0),
        'c_ctx': nrm(ks[3], (D_MODEL,), 1.0),
        'w_mod': nrm(ks[4], (DEPTH, D_MODEL, 6 * D_MODEL), 0.5 * D_MODEL ** -0.5),
        'b_mod': nrm(ks[5], (DEPTH, 6 * D_MODEL), 0.02),
        'norm_g': 1.0 + nrm(ks[6], (DEPTH, 4, D_MODEL), 0.05),
        'ab_w_in': nrm(ks[7], (N_EVEN, D_MODEL, AB_IN), D_MODEL ** -0.5),
        'ab_w_out': nrm(ks[8], (N_EVEN, AB_MIX, D_MODEL), AB_MIX ** -0.5),
        'ret_decay_exp': 5.0 + jnp.arange(RET_HEADS, dtype=f32)[None, None, :] + nrm(ks[9], (N_EVEN, 2, RET_HEADS), 0.1),
        'swa_sink': nrm(ks[10], (N_EVEN, SWA_HEADS), 1.0),
        'na_w_in': nrm(ks[11], (N_ODD, D_MODEL, 3 * NA_DIM), D_MODEL ** -0.5),
        'na_w_out': nrm(ks[12], (N_ODD, NA_DIM, D_MODEL), NA_DIM ** -0.5),
        'na_rpb': nrm(ks[13], (N_ODD, NA_HEADS, 2 * NA_ROWS - 1, 2 * NA_COLS - 1), 0.5),
        'ffn_w_up': nrm(ks[14], (DEPTH, D_MODEL, 2 * D_FF), D_MODEL ** -0.5),
        'ffn_conv_w': nrm(ks[15], (DEPTH, CONV_W, 2 * D_FF), CONV_W ** -0.5),
        'ffn_conv_b': nrm(ks[16], (DEPTH, 2 * D_FF), 0.02),
        'ffn_w_down': nrm(ks[17], (DEPTH, D_FF, D_MODEL), D_FF ** -0.5),
    }


def reference(x, c, ctx, c_ctx, w_mod, b_mod, norm_g, ab_w_in, ab_w_out, ret_decay_exp, swa_sink,
              na_w_in, na_w_out, na_rpb, ffn_w_up, ffn_conv_w, ffn_conv_b, ffn_w_down):
    b = x.shape[0]
    for l in range(DEPTH):
        last = l == DEPTH - 1
        mod_x = (jax.nn.silu(c) @ w_mod[l] + b_mod[l]).reshape(b, 6, 1, D_MODEL)
        mod_c = (jax.nn.silu(c_ctx) @ w_mod[l] + b_mod[l]).reshape(6, D_MODEL)
        hx = modulate(rmsnorm(x, norm_g[l, 0]), mod_x[:, 0], mod_x[:, 1])
        hc = modulate(rmsnorm(ctx, norm_g[l, 0]), mod_c[0], mod_c[1])
        if l % 2 == 0:
            e = l // 2
            ox, oc = mixer_ab(hx, hc, ab_w_in[e], ab_w_out[e], ret_decay_exp[e], swa_sink[e], not last)
        else:
            o = l // 2
            ox, oc = mixer_c(hx, hc, na_w_in[o], na_w_out[o], na_rpb[o], not last)
        x = x + mod_x[:, 2] * rmsnorm(ox, norm_g[l, 1])
        hx = modulate(rmsnorm(x, norm_g[l, 2]), mod_x[:, 3], mod_x[:, 4])
        x = x + mod_x[:, 5] * rmsnorm(conv_ffn(hx, ffn_w_up[l], ffn_conv_w[l], ffn_conv_b[l], ffn_w_down[l]), norm_g[l, 3])
        if not last:
            ctx = ctx + mod_c[2] * rmsnorm(oc, norm_g[l, 1])
            hc = modulate(rmsnorm(ctx, norm_g[l, 2]), mod_c[3], mod_c[4])
            ctx = ctx + mod_c[5] * rmsnorm(conv_ffn(hc, ffn_w_up[l], ffn_conv_w[l], ffn_conv_b[l], ffn_w_down[l]), norm_g[l, 3])
    return x
```

```cpp
#include <hip/hip_runtime.h>
#include <hip/hip_cooperative_groups.h>
#include <cstdio>
namespace cg = cooperative_groups;

#define LAS __attribute__((address_space(3)))
typedef unsigned short bf16_t;
typedef short bf16x8 __attribute__((ext_vector_type(8)));
typedef short s16x4 __attribute__((ext_vector_type(4)));
typedef float f32x4 __attribute__((ext_vector_type(4)));
typedef float f32x2 __attribute__((ext_vector_type(2)));
typedef unsigned u32x4 __attribute__((ext_vector_type(4)));
typedef unsigned u32x2 __attribute__((ext_vector_type(2)));

constexpr int DM = 1024, NBATCH = 32, SEQL = 2048, CTXL = 256;
constexpr int ML = NBATCH * SEQL;
constexpr int MC = NBATCH * CTXL;
constexpr int MT = ML + MC;
constexpr int ABIN = 2816, DFF = 2816, NUP = 5632, NA3 = 3072;
constexpr int NTHREADS = 512;
constexpr int LDS_BYTES = 147456;
constexpr float EPSN = 1e-6f;

constexpr size_t WS_H    = 0;
constexpr size_t WS_PX   = WS_H + (size_t)MT * 1024 * 2;
constexpr size_t WS_Y    = WS_PX + (size_t)MT * 3072 * 2;
constexpr size_t WS_OX   = WS_Y + (size_t)36864 * 2816 * 2;
constexpr size_t WS_CTX  = WS_OX + (size_t)MT * 1024 * 2;
constexpr size_t WS_WABI = WS_CTX + (size_t)MC * 1024 * 4;
constexpr size_t WS_WABO = WS_WABI + (size_t)2816 * 1024 * 2;
constexpr size_t WS_WNAI = WS_WABO + (size_t)1024 * 1024 * 2;
constexpr size_t WS_WNAO = WS_WNAI + (size_t)3072 * 1024 * 2;
constexpr size_t WS_WUP  = WS_WNAO + (size_t)1024 * 1024 * 2;
constexpr size_t WS_WDN  = WS_WUP + (size_t)2 * 5632 * 1024 * 2;
constexpr size_t WS_MOD  = WS_WDN + (size_t)2 * 1024 * 2816 * 2;
constexpr size_t WS_RRET = WS_MOD + (size_t)2 * 33 * 6144 * 4;
constexpr size_t WS_R2D  = WS_RRET + (size_t)2048 * 64 * 8;
constexpr size_t WS_END  = WS_R2D + (size_t)64 * 16 * 8;

struct Params {
    const float* x; const float* c; const float* ctx; const float* c_ctx; const float* w_mod; const float* b_mod; const float* norm_g;
    const float* ab_w_in; const float* ab_w_out; const float* ret_decay; const float* swa_sink;
    const float* na_w_in; const float* na_w_out; const float* na_rpb;
    const float* ffn_w_up; const float* ffn_conv_w; const float* ffn_conv_b; const float* ffn_w_down;
    float* out; unsigned char* ws;
};

__device__ __forceinline__ unsigned cvt_pk_bf16(float lo, float hi) { unsigned r; asm volatile("v_cvt_pk_bf16_f32 %0, %1, %2" : "=v"(r) : "v"(lo), "v"(hi)); return r; }
__device__ __forceinline__ float bf_lo(unsigned u) { return __uint_as_float(u << 16); }
__device__ __forceinline__ float bf_hi(unsigned u) { return __uint_as_float(u & 0xffff0000u); }
__device__ __forceinline__ float wave_sum(float v) {
#pragma unroll
    for (int o = 32; o >= 1; o >>= 1) v += __shfl_xor(v, o);
    return v;
}
__device__ __forceinline__ unsigned off256(unsigned row, unsigned ch) { return 256u * row + 16u * (ch ^ (((row & 3u) << 2) | ((row >> 2) & 3u))); }
__device__ __forceinline__ unsigned off128(unsigned row, unsigned ch) { return 128u * row + 16u * (ch ^ (row & 7u)); }
__device__ __forceinline__ s16x4 tr_read(LAS unsigned char* p) { return __builtin_amdgcn_ds_read_tr16_b64_v4i16((LAS s16x4*)p); }
__device__ __forceinline__ bf16x8 cat4(s16x4 a, s16x4 b) { return __builtin_shufflevector(a, b, 0, 1, 2, 3, 4, 5, 6, 7); }
__device__ __forceinline__ bf16x8 pack8(f32x4 a, f32x4 b) {
    u32x4 w; w.x = cvt_pk_bf16(a[0], a[1]); w.y = cvt_pk_bf16(a[2], a[3]); w.z = cvt_pk_bf16(b[0], b[1]); w.w = cvt_pk_bf16(b[2], b[3]);
    return __builtin_bit_cast(bf16x8, w);
}
#define MFMA16(a, b, c) __builtin_amdgcn_mfma_f32_16x16x32_bf16((a), (b), (c), 0, 0, 0)

namespace pg8 {
#define PG8_LAS __attribute__((address_space(3)))
typedef unsigned short bf16_t;
typedef short bf16x8 __attribute__((ext_vector_type(8)));
typedef float f32x4 __attribute__((ext_vector_type(4)));
typedef unsigned u32x4 __attribute__((ext_vector_type(4)));
constexpr int BM = 256, BK = 64, HALF = 128, HTB = HALF * BK * 2  , STAGE_BYTES = 8 * HTB, NXCD = 8, WGM = 8;

__host__ __device__ __forceinline__ int lds_byte(int r, int c) { const int st = (r >> 4) * 2 + (c >> 5), rr = r & 15, cc = c & 31, ob = rr * 64 + cc * 2; return st * 1024 + (ob ^ (((ob >> 9) & 1) << 5)); }
__host__ __device__ __forceinline__ void stage_rc(int b, int& R, int& C) { const int st = b / 1024, sb = b % 1024, swz = sb ^ (((sb >> 9) & 1) << 5); R = (st >> 1) * 16 + swz / 64; C = (st & 1) * 32 + (swz % 64) / 2; }
__host__ __device__ __forceinline__ int perm32(int rho) { const int n = rho >> 4, i = rho & 15; return 8 * (i >> 2) + 4 * n + (i & 3); }

struct Unit { int pm, pn; };
struct Gemm { const bf16_t* A; const bf16_t* Bt; int M, N, K; };

struct StaticOrder {
    int nM, nN, nwg, G, c;
    __host__ __device__ void init(int M, int N, int G_, int c_) { nM = M / BM; nN = N / BM; nwg = nM * nN; G = G_; c = c_; }
    __host__ __device__ bool next(int i, Unit& u) const {
        const long L = (long)i * G + c; if (L >= nwg) return false;
        int wgid = (int)L; { const int q = nwg / NXCD, r = nwg % NXCD, xcd = wgid % NXCD, off = wgid / NXCD; wgid = (xcd < r ? xcd * (q + 1) : r * (q + 1) + (xcd - r) * q) + off; }
        const int nig = WGM * nN, gid = wgid / nig, fm = gid * WGM, gsz = (nM - fm) < WGM ? (nM - fm) : WGM;
        u.pm = fm + ((wgid % nig) % gsz); u.pn = (wgid % nig) / gsz; return true;
    }
    __device__ __forceinline__ void a_ready(const Unit&) const {}
    __device__ __forceinline__ void done(const Unit&) const {}
};

__device__ __forceinline__ unsigned cvt_pk_bf16(float lo, float hi) { unsigned r; asm volatile("v_cvt_pk_bf16_f32 %0, %1, %2" : "=v"(r) : "v"(lo), "v"(hi)); return r; }
struct EpiOut {
    static constexpr bool PERM = true, AFTER_DRAIN = false;
    bf16_t* O; int ldc; int mode;
    const f32x4* rret; const f32x4* r2d;
    __device__ __forceinline__ void operator()(const f32x4 (&acc)[2][2][4][2], const Unit& u, int wr, int wc, int fr, int fq) const {
        const int row0 = u.pm * BM + wr * 64 + fr;
        const int colw = wc * 32 + 8 * fq;
        const bool lat = (u.pm < 256);
#pragma unroll
        for (int bj = 0; bj < 2; ++bj) {
            const int colbase = u.pn * BM + bj * HALF;
            const int col0 = colbase + colw;
            int kind = 0; float scale = 1.f;
            if (mode == 1) {
                if (colbase < 512) { kind = 1; }
                else if (colbase < 1024) { kind = 1; scale = 0.08838834764831845f; }
                else if (colbase < 2048) { }
                else if (colbase < 2560) { kind = 2; scale = 0.125f; }
                else if (colbase < 2688) { kind = 2; }
            } else if (mode == 2) { if (colbase < 1024) scale = 0.125f; }
            if (!lat) kind = 0;
#pragma unroll
            for (int ai = 0; ai < 2; ++ai)
#pragma unroll
                for (int m = 0; m < 4; ++m) {
                    const int row = row0 + ai * HALF + m * 16;
                    f32x4 v0 = acc[ai][bj][m][0] * scale, v1 = acc[ai][bj][m][1] * scale;
                    if (kind != 0) {
                        const int t = row & 2047;
                        const f32x4* tp;
                        if (kind == 1) tp = rret + ((t * 64 + ((col0 & 127) >> 1)) >> 1);
                        else { const int i0 = (col0 & 63) >> 1; const int pos = i0 < 16 ? (t >> 6) : (t & 63); tp = r2d + ((pos * 16 + (i0 & 15)) >> 1); }
                        const f32x4 cs0 = tp[0], cs1 = tp[1];
                        float a, b;
                        a = v0[0]; b = v0[1]; v0[0] = a * cs0[0] - b * cs0[1]; v0[1] = a * cs0[1] + b * cs0[0];
                        a = v0[2]; b = v0[3]; v0[2] = a * cs0[2] - b * cs0[3]; v0[3] = a * cs0[3] + b * cs0[2];
                        a = v1[0]; b = v1[1]; v1[0] = a * cs1[0] - b * cs1[1]; v1[1] = a * cs1[1] + b * cs1[0];
                        a = v1[2]; b = v1[3]; v1[2] = a * cs1[2] - b * cs1[3]; v1[3] = a * cs1[3] + b * cs1[2];
                    }
                    u32x4 w; w.x = cvt_pk_bf16(v0[0], v0[1]); w.y = cvt_pk_bf16(v0[2], v0[3]); w.z = cvt_pk_bf16(v1[0], v1[1]); w.w = cvt_pk_bf16(v1[2], v1[3]);
                    *(u32x4*)(O + (size_t)row * ldc + col0) = w;
                }
        }
    }
};

template <class Epi, class Sched, bool STAMP = false>
__device__ __forceinline__ void gemm_phase(PG8_LAS unsigned char* lds, const Gemm g, const Sched& S, const Epi& E, unsigned long long* stamps) {
    int tid_l = threadIdx.x; asm volatile("" : "+v"(tid_l));
    const int tid = tid_l, wid = __builtin_amdgcn_readfirstlane(tid >> 6), lane = tid & 63, wr = wid >> 2, wc = wid & 3, fr = lane & 15, fq = lane >> 4;
    const int K = g.K, nt = K / BK;
    int ts_lo = 0, ts_hi = 0, nts = 0; const unsigned long long rt_entry = STAMP ? (unsigned long long)wall_clock64() : 0ull;
#define PG8_STAMP() do { if (STAMP && wid == 0 && nts < 64) { const unsigned long long _c = (unsigned long long)clock64(); \
        ts_lo = (lane == nts) ? (int)(unsigned)_c : ts_lo; ts_hi = (lane == nts) ? (int)(unsigned)(_c >> 32) : ts_hi; ++nts; } } while (0)
    PG8_STAMP();
    unsigned voffA[2], voffB[2];
#pragma unroll
    for (int i = 0; i < 2; ++i) { int R, C; stage_rc(tid * 16 + i * 8192, R, C); const int Rb = Epi::PERM ? ((R & ~31) + perm32(R & 31)) : R;
        voffA[i] = (unsigned)(R * K + C) * 2u; voffB[i] = (unsigned)(Rb * K + C) * 2u; }
    const size_t kstep = (size_t)(BK * 2);
    const size_t hstep = (size_t)HALF * K * 2;
    const size_t tstep = 2 * hstep;
    const unsigned ldsw = (unsigned)wid * 1024u;
    const int aoff = lds_byte(wr * 64 + fr, fq * 8), boff = lds_byte(wc * 32 + fr, fq * 8);
#define PG8_SA(b, h) (((b) * 2 + (h)) * HTB)
#define PG8_SB(b, h) ((4 + (b) * 2 + (h)) * HTB)
#define PG8_STAGE(bufoff, gbase, voff) do { _Pragma("unroll") for (int _i = 0; _i < 2; ++_i) \
        __builtin_amdgcn_global_load_lds((const unsigned*)((const char*)(gbase) + (voff)[_i]), (PG8_LAS unsigned*)(lds + (bufoff) + ldsw + _i * 8192), 16, 0, 0); } while (0)
#define PG8_LDA(dst, b, h) do { _Pragma("unroll") for (int m = 0; m < 4; ++m) _Pragma("unroll") for (int k = 0; k < 2; ++k) dst[m][k] = *(const PG8_LAS bf16x8*)(lds + PG8_SA(b, h) + aoff + m * 2048 + k * 1024); } while (0)
#define PG8_LDB(dst, b, h) do { _Pragma("unroll") for (int n = 0; n < 2; ++n) _Pragma("unroll") for (int k = 0; k < 2; ++k) dst[n][k] = *(const PG8_LAS bf16x8*)(lds + PG8_SB(b, h) + boff + n * 2048 + k * 1024); } while (0)
#define PG8_MMA(ai, bj, At, Bt) do { __builtin_amdgcn_s_setprio(1); _Pragma("unroll") for (int m = 0; m < 4; ++m) _Pragma("unroll") for (int n = 0; n < 2; ++n) _Pragma("unroll") for (int k = 0; k < 2; ++k) \
        acc[ai][bj][m][n] = __builtin_amdgcn_mfma_f32_16x16x32_bf16(Bt[n][k], At[m][k], acc[ai][bj][m][n], 0, 0, 0); __builtin_amdgcn_s_setprio(0); } while (0)
#define PG8_WAIT_V(n) asm volatile("s_waitcnt vmcnt(" #n ")" ::: "memory")
#define PG8_WAIT_L(n) asm volatile("s_waitcnt lgkmcnt(" #n ")" ::: "memory")
#define PG8_BAR __builtin_amdgcn_s_barrier()
#define PG8_SCHED __builtin_amdgcn_sched_barrier(0)
    Unit cur, nxt; int ui = 0;
    if (!S.next(0, cur)) return;
    f32x4 acc[2][2][4][2];
#pragma unroll
    for (int a = 0; a < 2; ++a)
#pragma unroll
        for (int b = 0; b < 2; ++b)
#pragma unroll
            for (int m = 0; m < 4; ++m)
#pragma unroll
                for (int n = 0; n < 2; ++n) acc[a][b][m][n] = (f32x4){0.f, 0.f, 0.f, 0.f};
    bf16x8 At[4][2], B0[2][2], B1[2][2];
    const char* cA = (const char*)g.A + (size_t)cur.pm * tstep; const char* cB = (const char*)g.Bt + (size_t)cur.pn * tstep;
    S.a_ready(cur);
    PG8_STAGE(PG8_SB(0, 0), cB, voffB); PG8_STAGE(PG8_SA(0, 0), cA, voffA); PG8_STAGE(PG8_SB(0, 1), cB + hstep, voffB); PG8_STAGE(PG8_SA(0, 1), cA + hstep, voffA);
    if (wr == 1) PG8_BAR;
    PG8_WAIT_V(4); PG8_BAR;
    PG8_STAGE(PG8_SB(1, 0), cB + kstep, voffB); PG8_STAGE(PG8_SA(1, 0), cA + kstep, voffA); PG8_STAGE(PG8_SB(1, 1), cB + hstep + kstep, voffB);
    PG8_WAIT_V(6); PG8_BAR;
    PG8_STAMP();
    for (;;) {
        const bool has_next = S.next(ui + 1, nxt);
        const char* nA = has_next ? (const char*)g.A + (size_t)nxt.pm * tstep : cA; const char* nB = has_next ? (const char*)g.Bt + (size_t)nxt.pn * tstep : cB;
        for (int t = 0; t < nt; t += 2) {
            const bool last = (t == nt - 2);
            const char* a1 = cA + (size_t)(t + 1) * kstep;
            const char* a2 = last ? nA : cA + (size_t)(t + 2) * kstep; const char* b2 = last ? nB : cB + (size_t)(t + 2) * kstep;
            const char* a3 = a2 + kstep; const char* b3 = b2 + kstep;
            if (last && has_next) S.a_ready(nxt);
            PG8_LDB(B0, 0, 0); PG8_SCHED; PG8_LDA(At, 0, 0); PG8_STAGE(PG8_SA(1, 1), a1 + hstep, voffA);
            PG8_WAIT_L(8); PG8_BAR; PG8_WAIT_L(0); PG8_MMA(0, 0, At, B0); PG8_BAR; PG8_SCHED;
            PG8_LDB(B1, 0, 1); PG8_STAGE(PG8_SB(0, 0), b2, voffB);
            PG8_BAR; PG8_WAIT_L(0); PG8_MMA(0, 1, At, B1); PG8_BAR;
            PG8_LDA(At, 0, 1); PG8_STAGE(PG8_SA(0, 0), a2, voffA);
            PG8_BAR; PG8_WAIT_L(0); PG8_MMA(1, 0, At, B0); PG8_BAR; PG8_SCHED;
            PG8_STAGE(PG8_SB(0, 1), b2 + hstep, voffB);
            PG8_WAIT_V(6); PG8_BAR; PG8_MMA(1, 1, At, B1); PG8_BAR;
            PG8_LDB(B0, 1, 0); PG8_SCHED; PG8_LDA(At, 1, 0); PG8_STAGE(PG8_SA(0, 1), a2 + hstep, voffA);
            PG8_WAIT_L(8); PG8_BAR; PG8_WAIT_L(0); PG8_MMA(0, 0, At, B0); PG8_BAR; PG8_SCHED;
            PG8_LDB(B1, 1, 1); PG8_STAGE(PG8_SB(1, 0), b3, voffB);
            PG8_BAR; PG8_WAIT_L(0); PG8_MMA(0, 1, At, B1); PG8_BAR;
            PG8_LDA(At, 1, 1); PG8_STAGE(PG8_SA(1, 0), a3, voffA);
            PG8_BAR; PG8_WAIT_L(0); PG8_MMA(1, 0, At, B0); PG8_BAR; PG8_SCHED;
            PG8_STAGE(PG8_SB(1, 1), b3 + hstep, voffB);
            PG8_WAIT_V(6); PG8_BAR; PG8_MMA(1, 1, At, B1); PG8_BAR;
        }
        PG8_STAMP();
        if constexpr (!Epi::AFTER_DRAIN) { E(acc, cur, wr, wc, fr, fq); S.done(cur); }
        PG8_STAMP();
        if (!has_next) break;
#pragma unroll
        for (int a = 0; a < 2; ++a)
#pragma unroll
            for (int b = 0; b < 2; ++b)
#pragma unroll
                for (int m = 0; m < 4; ++m)
#pragma unroll
                    for (int n = 0; n < 2; ++n) acc[a][b][m][n] = (f32x4){0.f, 0.f, 0.f, 0.f};
        cur = nxt; cA = nA; cB = nB; ++ui;
    }
    PG8_WAIT_V(0);
    if (wr == 0) PG8_BAR;
    PG8_BAR;
    if constexpr (Epi::AFTER_DRAIN) { E.fused(acc, cur, wr, wc, fr, fq, lds, wid, lane); S.done(cur); }
    PG8_STAMP();
    if (STAMP && wid == 0) { stamps[lane] = lane < nts ? (((unsigned long long)(unsigned)ts_hi << 32) | (unsigned)ts_lo) : 0ull;
        if (lane == 62) stamps[62] = rt_entry; if (lane == 63) stamps[63] = (unsigned long long)wall_clock64(); }
#undef PG8_STAMP
#undef PG8_SA
#undef PG8_SB
#undef PG8_STAGE
#undef PG8_LDA
#undef PG8_LDB
#undef PG8_MMA
#undef PG8_WAIT_V
#undef PG8_WAIT_L
#undef PG8_BAR
#undef PG8_SCHED
}
}

__device__ __forceinline__ int tid_fresh() { int t = threadIdx.x; asm volatile("" : "+v"(t)); return t; }
__device__ __forceinline__ int perm_ab(int p) {
    if (p < 1024) { const int h = p >> 7, q = p & 127; return (h << 7) + (q >> 1) + ((q & 1) << 6); }
    if (p < 2048) return p;
    if (p < 2688) { const int hb = p & ~63, q = p & 63, i = q >> 1; return hb + (i < 16 ? i : 16 + i) + ((q & 1) << 4); }
    return p;
}
__device__ __forceinline__ int perm_up(int p) { const int q = p >> 3, e = p & 7; return e < 4 ? 4 * q + e : DFF + 4 * q + (e - 4); }

__device__ __forceinline__ void transpose_tile(const float* __restrict__ W, int K, int N, bf16_t* __restrict__ Wt, int ptype, int tile, LAS float* T) {
    const int ntn = N >> 6;
    const int tk = tile / ntn, tn = tile - tk * ntn;
    const int k0 = tk * 64, n0 = tn * 64, tid = tid_fresh();
    {
        const int j = tid & 63, i0 = tid >> 6, n = n0 + j;
        const int ncol = ptype == 1 ? perm_ab(n) : (ptype == 2 ? perm_up(n) : n);
        const float* src = W + (size_t)(k0 + i0) * N + ncol;
#pragma unroll
        for (int ii = 0; ii < 8; ++ii) T[j * 65 + i0 + 8 * ii] = src[(size_t)(8 * ii) * N];
    }
    __syncthreads();
    {
        const int r = tid >> 3, c = tid & 7;
        LAS float* s = T + r * 65 + c * 8;
        u32x4 w; w.x = cvt_pk_bf16(s[0], s[1]); w.y = cvt_pk_bf16(s[2], s[3]); w.z = cvt_pk_bf16(s[4], s[5]); w.w = cvt_pk_bf16(s[6], s[7]);
        *(u32x4*)(Wt + (size_t)(n0 + r) * K + k0 + c * 8) = w;
    }
    __syncthreads();
}

__device__ __forceinline__ void prep_phase(const Params& p, LAS unsigned char* lds) {
    unsigned char* ws = p.ws;
    const int tid = tid_fresh(), lane = tid & 63, w = tid >> 6;
    {
        f32x2* rret = (f32x2*)(ws + WS_RRET); f32x2* r2d = (f32x2*)(ws + WS_R2D);
        for (int idx = blockIdx.x * NTHREADS + tid; idx < 2048 * 64 + 64 * 16; idx += gridDim.x * NTHREADS) {
            if (idx < 2048 * 64) { const int t = idx >> 6, i = idx & 63; const float inv = powf(10000.0f, -(float)i / 64.0f); const float ang = (float)t * inv; f32x2 v; v.x = cosf(ang); v.y = sinf(ang); rret[idx] = v; }
            else { const int j = idx - 2048 * 64, pos = j >> 4, i = j & 15; const float inv = powf(10000.0f, -(float)i / 16.0f); const float ang = (float)pos * inv; f32x2 v; v.x = cosf(ang); v.y = sinf(ang); r2d[j] = v; }
        }
    }
    {
        LAS float* sil = (LAS float*)lds;
        float* mod = (float*)(ws + WS_MOD);
        for (int it = (int)gridDim.x - 1 - (int)blockIdx.x; it < 192; it += gridDim.x) {
            __syncthreads();
            for (int idx = tid; idx < 33 * 1024; idx += NTHREADS) { const float v = idx < 32 * 1024 ? p.c[idx] : p.c_ctx[idx - 32 * 1024]; sil[idx] = v / (1.0f + expf(-v)); }
            __syncthreads();
            const int l = it / 96, col0 = (it % 96) * 64;
            const float* wm = p.w_mod + (size_t)l * 1024 * 6144 + col0 + lane;
            float acc[33];
#pragma unroll
            for (int r = 0; r < 33; ++r) acc[r] = 0.f;
            for (int k = w * 128; k < w * 128 + 128; ++k) {
                const float wv = wm[(size_t)k * 6144];
#pragma unroll
                for (int r = 0; r < 33; ++r) acc[r] += sil[r * 1024 + k] * wv;
            }
            __syncthreads();
            LAS float* red = (LAS float*)lds;
#pragma unroll
            for (int r = 0; r < 33; ++r) red[(w * 33 + r) * 64 + lane] = acc[r];
            __syncthreads();
            for (int idx = tid; idx < 33 * 64; idx += NTHREADS) {
                const int r = idx >> 6, cc = idx & 63;
                float s = p.b_mod[l * 6144 + col0 + cc];
#pragma unroll
                for (int ww = 0; ww < 8; ++ww) s += red[(ww * 33 + r) * 64 + cc];
                mod[(size_t)(l * 33 + r) * 6144 + col0 + cc] = s;
            }
        }
        __syncthreads();
    }
    {
        LAS float* T = (LAS float*)lds;
        for (int t = blockIdx.x; t < 6208; t += gridDim.x) {
            if (t < 704) transpose_tile(p.ab_w_in, 1024, 2816, (bf16_t*)(ws + WS_WABI), 1, t, T);
            else if (t < 960) transpose_tile(p.ab_w_out, 1024, 1024, (bf16_t*)(ws + WS_WABO), 0, t - 704, T);
            else if (t < 1728) transpose_tile(p.na_w_in, 1024, 3072, (bf16_t*)(ws + WS_WNAI), 0, t - 960, T);
            else if (t < 1984) transpose_tile(p.na_w_out, 1024, 1024, (bf16_t*)(ws + WS_WNAO), 0, t - 1728, T);
            else if (t < 3392) transpose_tile(p.ffn_w_up, 1024, 5632, (bf16_t*)(ws + WS_WUP), 2, t - 1984, T);
            else if (t < 4800) transpose_tile(p.ffn_w_up + (size_t)1024 * 5632, 1024, 5632, (bf16_t*)(ws + WS_WUP) + (size_t)5632 * 1024, 2, t - 3392, T);
            else if (t < 5504) transpose_tile(p.ffn_w_down, 2816, 1024, (bf16_t*)(ws + WS_WDN), 0, t - 4800, T);
            else transpose_tile(p.ffn_w_down + (size_t)2816 * 1024, 2816, 1024, (bf16_t*)(ws + WS_WDN) + (size_t)1024 * 2816, 0, t - 5504, T);
        }
    }
}

__device__ __forceinline__ void rowwise_phase(const float* xin_lat, const float* xin_ctx, float* xout_lat, float* xout_ctx, const bf16_t* ox,
                                           const float* gpost, const float* modgate, const float* gpre, const float* modshift, const float* modscale, bf16_t* H, int nrows) {
    const int tid = tid_fresh(), lane = tid & 63, gw = blockIdx.x * 8 + (tid >> 6), nw = gridDim.x * 8;
    for (int row = gw; row < nrows; row += nw) {
        const bool lat = row < ML; const int mrow = lat ? (row >> 11) : 32;
        const float* xi = lat ? xin_lat + (size_t)row * 1024 : xin_ctx + (size_t)(row - ML) * 1024;
        f32x4 v[4];
#pragma unroll
        for (int i = 0; i < 4; ++i) v[i] = *(const f32x4*)(xi + lane * 4 + 256 * i);
        if (ox) {
            f32x4 o[4]; float ss = 0.f;
#pragma unroll
            for (int i = 0; i < 4; ++i) {
                const u32x2 t = *(const u32x2*)(ox + (size_t)row * 1024 + lane * 4 + 256 * i);
                o[i] = (f32x4){bf_lo(t.x), bf_hi(t.x), bf_lo(t.y), bf_hi(t.y)};
                ss += o[i][0] * o[i][0] + o[i][1] * o[i][1] + o[i][2] * o[i][2] + o[i][3] * o[i][3];
            }
            ss = wave_sum(ss);
            const float rinv = rsqrtf(ss * (1.0f / 1024.0f) + EPSN);
            const float* gate = modgate + (size_t)mrow * 6144;
            float* xo = lat ? xout_lat + (size_t)row * 1024 : xout_ctx + (size_t)(row - ML) * 1024;
#pragma unroll
            for (int i = 0; i < 4; ++i) {
                const int col = lane * 4 + 256 * i;
                const f32x4 g = *(const f32x4*)(gpost + col), gt = *(const f32x4*)(gate + col);
                v[i] += gt * (o[i] * rinv * g);
                *(f32x4*)(xo + col) = v[i];
            }
        }
        if (H) {
            float ss = 0.f;
#pragma unroll
            for (int i = 0; i < 4; ++i) ss += v[i][0] * v[i][0] + v[i][1] * v[i][1] + v[i][2] * v[i][2] + v[i][3] * v[i][3];
            ss = wave_sum(ss);
            const float rinv = rsqrtf(ss * (1.0f / 1024.0f) + EPSN);
            const float* sh = modshift + (size_t)mrow * 6144; const float* sc = modscale + (size_t)mrow * 6144;
#pragma unroll
            for (int i = 0; i < 4; ++i) {
                const int col = lane * 4 + 256 * i;
                const f32x4 g = *(const f32x4*)(gpre + col), s1 = *(const f32x4*)(sc + col), s0 = *(const f32x4*)(sh + col);
                const f32x4 h = (v[i] * rinv * g) * (s1 + 1.0f) + s0;
                u32x2 wv; wv.x = cvt_pk_bf16(h[0], h[1]); wv.y = cvt_pk_bf16(h[2], h[3]);
                *(u32x2*)(H + (size_t)row * 1024 + col) = wv;
            }
        }
    }
}

__device__ __forceinline__ float silu_f(float x) { return x / (1.0f + __expf(-x)); }
__device__ __forceinline__ void convact_phase(const bf16_t* U, bf16_t* ACT, const float* cw, const float* cb, int row0g, int nrows) {
    const int tid = tid_fresh(), lane = tid & 63, gw = blockIdx.x * 8 + (tid >> 6), nw = gridDim.x * 8;
    const int nitems = (nrows >> 5) * 11;
    for (int it = gw; it < nitems; it += nw) {
        const int slab = it % 11, rb = it / 11;
        const int q = slab * 64 + lane;
        const f32x4 wa0 = *(const f32x4*)(cw + 4 * q), wa1 = *(const f32x4*)(cw + NUP + 4 * q), wa2 = *(const f32x4*)(cw + 2 * NUP + 4 * q), ba = *(const f32x4*)(cb + 4 * q);
        const f32x4 wg0 = *(const f32x4*)(cw + DFF + 4 * q), wg1 = *(const f32x4*)(cw + NUP + DFF + 4 * q), wg2 = *(const f32x4*)(cw + 2 * NUP + DFF + 4 * q), bg = *(const f32x4*)(cb + DFF + 4 * q);
        const int r0 = rb * 32, R0 = row0g + r0;
        const int pos0 = R0 < ML ? (R0 & 2047) : ((R0 - ML) & 255), len = R0 < ML ? 2048 : 256;
        const bf16_t* up = U + (size_t)r0 * NUP + 8 * q;
        const u32x4 zero = (u32x4){0u, 0u, 0u, 0u};
        u32x4 prev = zero, cur;
        if (pos0 > 0) prev = *(const u32x4*)(up - NUP);
        cur = *(const u32x4*)(up);
        for (int g8 = 0; g8 < 4; ++g8) {
            u32x4 nx[8];
#pragma unroll
            for (int j = 0; j < 8; ++j) { const int rr = g8 * 8 + j; nx[j] = zero; if (pos0 + rr + 1 < len) nx[j] = *(const u32x4*)(up + (size_t)(rr + 1) * NUP); }
#pragma unroll
            for (int j = 0; j < 8; ++j) {
                const int rr = g8 * 8 + j;
                const u32x4 nxt = nx[j];
                const f32x4 ap = (f32x4){bf_lo(prev.x), bf_hi(prev.x), bf_lo(prev.y), bf_hi(prev.y)}, gp = (f32x4){bf_lo(prev.z), bf_hi(prev.z), bf_lo(prev.w), bf_hi(prev.w)};
                const f32x4 ac = (f32x4){bf_lo(cur.x), bf_hi(cur.x), bf_lo(cur.y), bf_hi(cur.y)}, gc = (f32x4){bf_lo(cur.z), bf_hi(cur.z), bf_lo(cur.w), bf_hi(cur.w)};
                const f32x4 an = (f32x4){bf_lo(nxt.x), bf_hi(nxt.x), bf_lo(nxt.y), bf_hi(nxt.y)}, gn = (f32x4){bf_lo(nxt.z), bf_hi(nxt.z), bf_lo(nxt.w), bf_hi(nxt.w)};
                const f32x4 a = ba + wa0 * ap + wa1 * ac + wa2 * an;
                const f32x4 g = bg + wg0 * gp + wg1 * gc + wg2 * gn;
                u32x2 wv; wv.x = cvt_pk_bf16(silu_f(g[0]) * a[0], silu_f(g[1]) * a[1]); wv.y = cvt_pk_bf16(silu_f(g[2]) * a[2], silu_f(g[3]) * a[3]);
                *(u32x2*)(ACT + (size_t)(r0 + rr) * DFF + 4 * q) = wv;
                prev = cur; cur = nxt;
            }
        }
    }
}

__device__ __forceinline__ void combine_phase(const bf16_t* Yf, const bf16_t* Yb, const bf16_t* PX, bf16_t* Y) {
    const int tid = tid_fresh(), lane = tid & 63, gw = blockIdx.x * 8 + (tid >> 6), nw = gridDim.x * 8;
    for (int row = gw; row < MT; row += nw) {
        const u32x4 a = *(const u32x4*)(Yf + (size_t)row * 512 + lane * 8), b = *(const u32x4*)(Yb + (size_t)row * 512 + lane * 8);
        const u32x4 g = *(const u32x4*)(PX + (size_t)row * ABIN + 1536 + lane * 8);
        float y[8], gg[8];
        y[0] = bf_lo(a.x) + bf_lo(b.x); y[1] = bf_hi(a.x) + bf_hi(b.x); y[2] = bf_lo(a.y) + bf_lo(b.y); y[3] = bf_hi(a.y) + bf_hi(b.y);
        y[4] = bf_lo(a.z) + bf_lo(b.z); y[5] = bf_hi(a.z) + bf_hi(b.z); y[6] = bf_lo(a.w) + bf_lo(b.w); y[7] = bf_hi(a.w) + bf_hi(b.w);
        gg[0] = bf_lo(g.x); gg[1] = bf_hi(g.x); gg[2] = bf_lo(g.y); gg[3] = bf_hi(g.y); gg[4] = bf_lo(g.z); gg[5] = bf_hi(g.z); gg[6] = bf_lo(g.w); gg[7] = bf_hi(g.w);
        float ss = 0.f;
#pragma unroll
        for (int i = 0; i < 8; ++i) ss += y[i] * y[i];
        ss += __shfl_xor(ss, 1); ss += __shfl_xor(ss, 2); ss += __shfl_xor(ss, 4); ss += __shfl_xor(ss, 8);
        const float rinv = rsqrtf(ss * (1.0f / 128.0f) + EPSN);
        float o[8];
#pragma unroll
        for (int i = 0; i < 8; ++i) o[i] = y[i] * rinv * silu_f(gg[i]);
        u32x4 wv; wv.x = cvt_pk_bf16(o[0], o[1]); wv.y = cvt_pk_bf16(o[2], o[3]); wv.z = cvt_pk_bf16(o[4], o[5]); wv.w = cvt_pk_bf16(o[6], o[7]);
        *(u32x4*)(Y + (size_t)row * 1024 + lane * 8) = wv;
    }
}

__device__ __forceinline__ u32x4 scale8(u32x4 v, float s) {
    u32x4 r;
    r.x = cvt_pk_bf16(bf_lo(v.x) * s, bf_hi(v.x) * s); r.y = cvt_pk_bf16(bf_lo(v.y) * s, bf_hi(v.y) * s);
    r.z = cvt_pk_bf16(bf_lo(v.z) * s, bf_hi(v.z) * s); r.w = cvt_pk_bf16(bf_lo(v.w) * s, bf_hi(v.w) * s);
    return r;
}
__device__ __forceinline__ void retention_phase(const Params& p, LAS unsigned char* lds, const bf16_t* PX, bf16_t* Yf, bf16_t* Yb) {
    const int tid = tid_fresh(), lane = tid & 63, w = __builtin_amdgcn_readfirstlane(tid >> 6), l15 = lane & 15, quad = lane >> 4, qq = l15 >> 2, pp = lane & 3;
    LAS unsigned char* Qs = lds; LAS unsigned char* Ks = lds + 32768; LAS unsigned char* Vs = lds + 65536; LAS unsigned char* As = lds + 98304;
    for (int item = blockIdx.x; item < 256; item += gridDim.x) {
        const int dir = item & 1, h = (item >> 1) & 3, b = item >> 3;
        const float de = p.ret_decay[dir * 4 + h];
        const float lg2 = log1pf(-exp2f(-de)) * 1.4426950408889634f;
        const float cdec = exp2f(lg2 * 128.0f);
        f32x4 S[8];
#pragma unroll
        for (int i = 0; i < 8; ++i) S[i] = (f32x4){0.f, 0.f, 0.f, 0.f};
        bf16_t* Yo = dir ? Yb : Yf;
        for (int s = 0; s < 18; ++s) {
            int c0;
            if (s < 2) { const int ch = dir ? 1 - s : s; c0 = ML + b * 256 + ch * 128; }
            else { const int ch = dir ? 17 - s : s - 2; c0 = b * 2048 + ch * 128; }
            __syncthreads();
#pragma unroll
            for (int c = 0; c < 4; ++c) {
                const int idx = tid + 512 * c, i = idx >> 4, ch = idx & 15;
                const int tok = dir ? c0 + 127 - i : c0 + i;
                const bf16_t* src = PX + (size_t)tok * ABIN + h * 128 + ch * 8;
                const u32x4 qv = *(const u32x4*)(src), kv = *(const u32x4*)(src + 512), vv = *(const u32x4*)(src + 1024);
                const unsigned o = off256(i, ch);
                *(LAS u32x4*)(Qs + o) = qv; *(LAS u32x4*)(Vs + o) = vv;
                *(LAS u32x4*)(Ks + o) = scale8(kv, exp2f(lg2 * (float)(127 - i)));
            }
            __syncthreads();
            {
                bf16x8 qf[4];
#pragma unroll
                for (int ks = 0; ks < 4; ++ks) qf[ks] = *(LAS bf16x8*)(Qs + off256(16 * w + l15, 4 * ks + quad));
                const int i = 16 * w + l15;
                const float rowsc = exp2f(lg2 * (float)(i - 127));
#pragma unroll
                for (int nt = 0; nt < 8; ++nt) {
                    f32x4 at = (f32x4){0.f, 0.f, 0.f, 0.f};
                    if (nt <= w) {
#pragma unroll
                        for (int ks = 0; ks < 4; ++ks) { const bf16x8 kf = *(LAS bf16x8*)(Ks + off256(16 * nt + l15, 4 * ks + quad)); at = MFMA16(kf, qf[ks], at); }
#pragma unroll
                        for (int jj = 0; jj < 4; ++jj) { const int diff = i - (16 * nt + 4 * quad + jj); const bool keep = dir ? (diff > 0) : (diff >= 0); at[jj] = keep ? at[jj] * rowsc : 0.f; }
                    }
                    u32x2 wv; wv.x = cvt_pk_bf16(at[0], at[1]); wv.y = cvt_pk_bf16(at[2], at[3]);
                    *(LAS u32x2*)(As + off256(16 * w + l15, 2 * nt + (quad >> 1)) + 8 * (quad & 1)) = wv;
                }
            }
            f32x4 o2[8];
            {
                bf16x8 sf[4];
#pragma unroll
                for (int pk = 0; pk < 4; ++pk) sf[pk] = pack8(S[2 * pk], S[2 * pk + 1]);
#pragma unroll
                for (int it = 0; it < 8; ++it) {
                    o2[it] = (f32x4){0.f, 0.f, 0.f, 0.f};
#pragma unroll
                    for (int pk = 0; pk < 4; ++pk) {
                        const s16x4 qa = *(LAS s16x4*)(Qs + off256(16 * it + l15, 4 * pk + (quad >> 1)) + 8 * (quad & 1));
                        const s16x4 qb = *(LAS s16x4*)(Qs + off256(16 * it + l15, 4 * pk + 2 + (quad >> 1)) + 8 * (quad & 1));
                        o2[it] = MFMA16(sf[pk], cat4(qa, qb), o2[it]);
                    }
                }
            }
            __syncthreads();
            bf16x8 vf[4];
#pragma unroll
            for (int ks = 0; ks < 4; ++ks) {
                const unsigned r1 = 32 * ks + 8 * quad + qq;
                vf[ks] = cat4(tr_read(Vs + off256(r1, 2 * w + (pp >> 1)) + 8 * (pp & 1)), tr_read(Vs + off256(r1 + 4, 2 * w + (pp >> 1)) + 8 * (pp & 1)));
            }
#pragma unroll
            for (int it = 0; it < 8; ++it) {
                f32x4 o1 = (f32x4){0.f, 0.f, 0.f, 0.f};
#pragma unroll
                for (int ks = 0; ks < 4; ++ks) if (ks <= (it >> 1)) { const bf16x8 af = *(LAS bf16x8*)(As + off256(16 * it + l15, 4 * ks + quad)); o1 = MFMA16(vf[ks], af, o1); }
                const int i = 16 * it + l15;
                const float qd = exp2f(lg2 * (float)(i + 1));
                const int tok = dir ? c0 + 127 - i : c0 + i;
                u32x2 wv; wv.x = cvt_pk_bf16(o1[0] + qd * o2[it][0], o1[1] + qd * o2[it][1]); wv.y = cvt_pk_bf16(o1[2] + qd * o2[it][2], o1[3] + qd * o2[it][3]);
                *(u32x2*)(Yo + (size_t)tok * 512 + h * 128 + 16 * w + 4 * quad) = wv;
            }
#pragma unroll
            for (int dt = 0; dt < 8; ++dt) {
                f32x4 acc = S[dt] * cdec;
#pragma unroll
                for (int ks = 0; ks < 4; ++ks) {
                    const unsigned r1 = 32 * ks + 8 * quad + qq;
                    const bf16x8 kf = cat4(tr_read(Ks + off256(r1, 2 * dt + (pp >> 1)) + 8 * (pp & 1)), tr_read(Ks + off256(r1 + 4, 2 * dt + (pp >> 1)) + 8 * (pp & 1)));
                    acc = MFMA16(kf, vf[ks], acc);
                }
                S[dt] = acc;
            }
        }
    }
    __syncthreads();
}

__device__ __forceinline__ void swa_phase(const Params& p, LAS unsigned char* lds, const bf16_t* PX, bf16_t* Y) {
    const int tid = tid_fresh(), lane = tid & 63, w = __builtin_amdgcn_readfirstlane(tid >> 6), l15 = lane & 15, quad = lane >> 4, qq = l15 >> 2, pp = lane & 3;
    LAS unsigned char* Ks = lds; LAS unsigned char* Vs = lds + 16384;
    for (int item = blockIdx.x; item < 1152; item += gridDim.x) {
        const bool isctx = item >= 1024;
        int b, kvh, qb;
        if (!isctx) { qb = item & 15; kvh = (item >> 4) & 1; b = item >> 5; } else { const int t = item - 1024; qb = t & 1; kvh = (t >> 1) & 1; b = t >> 2; }
        const int qh = kvh * 4 + (w >> 1);
        const int qpos0 = qb * 128 + 64 * (w & 1);
        const size_t qrow0 = isctx ? (size_t)ML + b * 256 + qpos0 : (size_t)b * 2048 + qpos0;
        bf16x8 qf[4][2];
#pragma unroll
        for (int it = 0; it < 4; ++it)
#pragma unroll
            for (int ks = 0; ks < 2; ++ks) qf[it][ks] = *(const bf16x8*)(PX + (qrow0 + 16 * it + l15) * ABIN + 2048 + qh * 64 + 32 * ks + 8 * quad);
        const float sink = p.swa_sink[qh];
        float mrun[4], lrun[4]; f32x4 o[4][4];
#pragma unroll
        for (int it = 0; it < 4; ++it) { mrun[it] = sink; lrun[it] = 0.f;
#pragma unroll
            for (int vt = 0; vt < 4; ++vt) o[vt][it] = (f32x4){0.f, 0.f, 0.f, 0.f}; }
        for (int c = isctx ? 3 : 0; c < 5; ++c) {
            const bool local = c < 3;
            const int kstart = (qb - 1 + c) * 128;
            if (local && (kstart < 0 || kstart >= 2048)) continue;
            const size_t krow0 = local ? (size_t)b * 2048 + kstart : (size_t)ML + b * 256 + (c - 3) * 128;
            __syncthreads();
#pragma unroll
            for (int cc = 0; cc < 2; ++cc) {
                const int idx = tid + 512 * cc, j = idx >> 3, ch = idx & 7;
                const bf16_t* src = PX + (krow0 + j) * ABIN + 2560 + kvh * 64 + ch * 8;
                const u32x4 kv = *(const u32x4*)(src), vv = *(const u32x4*)(src + 128);
                *(LAS u32x4*)(Ks + off128(j, ch)) = kv; *(LAS u32x4*)(Vs + off128(j, ch)) = vv;
            }
            __syncthreads();
            for (int kk = 0; kk < 4; ++kk) {
                const int g0 = kstart + 32 * kk;
                if (local && (g0 + 31 < qpos0 - 128 || g0 > qpos0 + 63 + 128)) continue;
                f32x4 st[4][2];
#pragma unroll
                for (int it = 0; it < 4; ++it) { st[it][0] = (f32x4){0.f, 0.f, 0.f, 0.f}; st[it][1] = (f32x4){0.f, 0.f, 0.f, 0.f}; }
#pragma unroll
                for (int jt = 0; jt < 2; ++jt)
#pragma unroll
                    for (int ks = 0; ks < 2; ++ks) {
                        const bf16x8 kf = *(LAS bf16x8*)(Ks + off128(32 * kk + 16 * jt + l15, 4 * ks + quad));
#pragma unroll
                        for (int it = 0; it < 4; ++it) st[it][jt] = MFMA16(kf, qf[it][ks], st[it][jt]);
                    }
                bf16x8 pf[4];
#pragma unroll
                for (int it = 0; it < 4; ++it) {
                    float mx = -1e30f;
                    if (local) {
                        const int qpos = qpos0 + 16 * it + l15;
#pragma unroll
                        for (int jt = 0; jt < 2; ++jt)
#pragma unroll
                            for (int jj = 0; jj < 4; ++jj) { const int d = qpos - (g0 + 16 * jt + 4 * quad + jj); if (d > 128 || d < -128) st[it][jt][jj] = -1e30f; }
                    }
#pragma unroll
                    for (int jt = 0; jt < 2; ++jt)
#pragma unroll
                        for (int jj = 0; jj < 4; ++jj) mx = fmaxf(mx, st[it][jt][jj]);
                    mx = fmaxf(mx, __shfl_xor(mx, 16)); mx = fmaxf(mx, __shfl_xor(mx, 32));
                    const float mnew = fmaxf(mrun[it], mx);
                    const float sc = __expf(mrun[it] - mnew);
                    float ps = 0.f;
#pragma unroll
                    for (int jt = 0; jt < 2; ++jt)
#pragma unroll
                        for (int jj = 0; jj < 4; ++jj) { const float e = __expf(st[it][jt][jj] - mnew); st[it][jt][jj] = e; ps += e; }
                    lrun[it] = lrun[it] * sc + ps; mrun[it] = mnew;
#pragma unroll
                    for (int vt = 0; vt < 4; ++vt) o[vt][it] *= sc;
                    pf[it] = pack8(st[it][0], st[it][1]);
                }
#pragma unroll
                for (int vt = 0; vt < 4; ++vt) {
                    const unsigned r1 = 32 * kk + 4 * quad + qq;
                    const bf16x8 vf = cat4(tr_read(Vs + off128(r1, 2 * vt + (pp >> 1)) + 8 * (pp & 1)), tr_read(Vs + off128(r1 + 16, 2 * vt + (pp >> 1)) + 8 * (pp & 1)));
#pragma unroll
                    for (int it = 0; it < 4; ++it) o[vt][it] = MFMA16(vf, pf[it], o[vt][it]);
                }
            }
        }
#pragma unroll
        for (int it = 0; it < 4; ++it) {
            float lt = lrun[it]; lt += __shfl_xor(lt, 16); lt += __shfl_xor(lt, 32);
            lt += __expf(sink - mrun[it]);
            const float inv = 1.0f / lt;
            bf16_t* dst = Y + (qrow0 + 16 * it + l15) * 1024 + 512 + qh * 64 + 4 * quad;
#pragma unroll
            for (int vt = 0; vt < 4; ++vt) { u32x2 wv; wv.x = cvt_pk_bf16(o[vt][it][0] * inv, o[vt][it][1] * inv); wv.y = cvt_pk_bf16(o[vt][it][2] * inv, o[vt][it][3] * inv); *(u32x2*)(dst + 16 * vt) = wv; }
        }
    }
    __syncthreads();
}

__device__ __forceinline__ void na_phase(const Params& p, LAS unsigned char* lds, const bf16_t* QKV, bf16_t* Y) {
    const int tid = tid_fresh(), lane = tid & 63, w = __builtin_amdgcn_readfirstlane(tid >> 6), l15 = lane & 15, quad = lane >> 4, qq = l15 >> 2, pp = lane & 3;
    LAS unsigned char* Ks = lds; LAS unsigned char* Vs = lds + 32768; LAS float* rp = (LAS float*)(lds + 65536);
    const int hh = w >> 2, m = w & 3;
    const int sup0 = min(max(16 * m - 8, 0), 32);
    const int qc = 16 * m + l15, qstart = min(max(qc - 8, 0), 48);
    for (int item = blockIdx.x; item < 8192; item += gridDim.x) {
        const int hp = item & 7, r = (item >> 3) & 31, b = item >> 8;
        const int h = 2 * hp + hh;
        const int rs = min(max(r - 4, 0), 24);
        __syncthreads();
        for (int idx = tid; idx < 930; idx += NTHREADS) rp[idx] = p.na_rpb[hp * 930 + idx];
        const size_t qtok = (size_t)b * 2048 + r * 64 + 16 * m + l15;
        bf16x8 qf[2];
#pragma unroll
        for (int ks = 0; ks < 2; ++ks) qf[ks] = *(const bf16x8*)(QKV + qtok * NA3 + h * 64 + 32 * ks + 8 * quad);
        float mrun = -1e30f, lrun = 0.f; f32x4 o[4];
#pragma unroll
        for (int vt = 0; vt < 4; ++vt) o[vt] = (f32x4){0.f, 0.f, 0.f, 0.f};
        for (int c = 0; c < 6; ++c) {
            const bool local = c < 4;
            __syncthreads();
#pragma unroll
            for (int cc = 0; cc < 4; ++cc) {
                const int idx = tid + 512 * cc, j = idx >> 4, ch = idx & 15;
                const size_t tok = local ? (size_t)b * 2048 + (rs + 2 * c + (j >> 6)) * 64 + (j & 63) : (size_t)ML + b * 256 + (c - 4) * 128 + j;
                const bf16_t* src = QKV + tok * NA3 + 1024 + hp * 128 + ch * 8;
                const u32x4 kv = *(const u32x4*)(src), vv = *(const u32x4*)(src + 1024);
                *(LAS u32x4*)(Ks + off256(j, ch)) = kv; *(LAS u32x4*)(Vs + off256(j, ch)) = vv;
            }
            __syncthreads();
            const int nst = local ? 1 : 2;
            for (int st = 0; st < nst; ++st) {
                f32x4 s[2][2];
#pragma unroll
                for (int gi = 0; gi < 2; ++gi) {
                    const int key0 = local ? 64 * gi + sup0 : 64 * st + 32 * gi;
#pragma unroll
                    for (int jt = 0; jt < 2; ++jt) {
                        s[gi][jt] = (f32x4){0.f, 0.f, 0.f, 0.f};
#pragma unroll
                        for (int ks = 0; ks < 2; ++ks) { const bf16x8 kf = *(LAS bf16x8*)(Ks + off256(key0 + 16 * jt + l15, 8 * hh + 4 * ks + quad)); s[gi][jt] = MFMA16(kf, qf[ks], s[gi][jt]); }
                    }
                }
                if (local) {
#pragma unroll
                    for (int gi = 0; gi < 2; ++gi) {
                        const int kr = rs + 2 * c + gi;
#pragma unroll
                        for (int jt = 0; jt < 2; ++jt)
#pragma unroll
                            for (int jj = 0; jj < 4; ++jj) {
                                const int kc = sup0 + 16 * jt + 4 * quad + jj;
                                const bool valid = (kc >= qstart) && (kc < qstart + 16);
                                const int bi = valid ? (kr - r + 7) * 31 + (kc - qc + 15) : 0;
                                const float bias = rp[hh * 465 + bi];
                                s[gi][jt][jj] = valid ? s[gi][jt][jj] + bias : -1e30f;
                            }
                    }
                }
                float mx = -1e30f;
#pragma unroll
                for (int gi = 0; gi < 2; ++gi)
#pragma unroll
                    for (int jt = 0; jt < 2; ++jt)
#pragma unroll
                        for (int jj = 0; jj < 4; ++jj) mx = fmaxf(mx, s[gi][jt][jj]);
                mx = fmaxf(mx, __shfl_xor(mx, 16)); mx = fmaxf(mx, __shfl_xor(mx, 32));
                const float mnew = fmaxf(mrun, mx);
                const float sc = __expf(mrun - mnew);
                float ps = 0.f;
#pragma unroll
                for (int gi = 0; gi < 2; ++gi)
#pragma unroll
                    for (int jt = 0; jt < 2; ++jt)
#pragma unroll
                        for (int jj = 0; jj < 4; ++jj) { const float e = __expf(s[gi][jt][jj] - mnew); s[gi][jt][jj] = e; ps += e; }
                lrun = lrun * sc + ps; mrun = mnew;
#pragma unroll
                for (int vt = 0; vt < 4; ++vt) o[vt] *= sc;
#pragma unroll
                for (int gi = 0; gi < 2; ++gi) {
                    const int key0 = local ? 64 * gi + sup0 : 64 * st + 32 * gi;
                    const bf16x8 pf = pack8(s[gi][0], s[gi][1]);
                    const unsigned r1 = key0 + 4 * quad + qq;
#pragma unroll
                    for (int vt = 0; vt < 4; ++vt) {
                        const bf16x8 vf = cat4(tr_read(Vs + off256(r1, 8 * hh + 2 * vt + (pp >> 1)) + 8 * (pp & 1)), tr_read(Vs + off256(r1 + 16, 8 * hh + 2 * vt + (pp >> 1)) + 8 * (pp & 1)));
                        o[vt] = MFMA16(vf, pf, o[vt]);
                    }
                }
            }
        }
        float lt = lrun; lt += __shfl_xor(lt, 16); lt += __shfl_xor(lt, 32);
        const float inv = 1.0f / lt;
        bf16_t* dst = Y + qtok * 1024 + h * 64 + 4 * quad;
#pragma unroll
        for (int vt = 0; vt < 4; ++vt) { u32x2 wv; wv.x = cvt_pk_bf16(o[vt][0] * inv, o[vt][1] * inv); wv.y = cvt_pk_bf16(o[vt][2] * inv, o[vt][3] * inv); *(u32x2*)(dst + 16 * vt) = wv; }
    }
    __syncthreads();
}


__device__ __forceinline__ void run_gemm(LAS unsigned char* lds, const bf16_t* A, const bf16_t* Bt, int M, int N, int K, bf16_t* O, int ldc, int mode, const unsigned char* ws) {
    pg8::Gemm g{A, Bt, M, N, K};
    pg8::StaticOrder S; S.init(M, N, (int)gridDim.x, (int)blockIdx.x);
    pg8::EpiOut E{O, ldc, mode, (const f32x4*)(ws + WS_RRET), (const f32x4*)(ws + WS_R2D)};
    pg8::gemm_phase<pg8::EpiOut, pg8::StaticOrder, false>(lds, g, S, E, nullptr);
}

__global__ void __launch_bounds__(NTHREADS, 2) hybrid_fwd_megakernel(Params p) {
    extern __shared__ __attribute__((aligned(16))) unsigned char lds_raw[];
    LAS unsigned char* lds = (LAS unsigned char*)lds_raw;
    cg::grid_group grid = cg::this_grid();
    unsigned char* ws = p.ws;
    bf16_t* H = (bf16_t*)(ws + WS_H); bf16_t* PX = (bf16_t*)(ws + WS_PX); bf16_t* Y = (bf16_t*)(ws + WS_Y); bf16_t* OX = (bf16_t*)(ws + WS_OX);
    bf16_t* U = PX; bf16_t* ACT = Y; bf16_t* Yf = OX; bf16_t* Yb = OX + (size_t)MT * 512;
    float* CTXR = (float*)(ws + WS_CTX);
    const float* mod0 = (const float*)(ws + WS_MOD); const float* mod1 = mod0 + 33 * 6144;
    const bf16_t* WABI = (const bf16_t*)(ws + WS_WABI); const bf16_t* WABO = (const bf16_t*)(ws + WS_WABO);
    const bf16_t* WNAI = (const bf16_t*)(ws + WS_WNAI); const bf16_t* WNAO = (const bf16_t*)(ws + WS_WNAO);
    const bf16_t* WUP = (const bf16_t*)(ws + WS_WUP); const bf16_t* WDN = (const bf16_t*)(ws + WS_WDN);
    const float* ng0 = p.norm_g; const float* ng1 = p.norm_g + 4096;

    prep_phase(p, lds);
    grid.sync();
    rowwise_phase(p.x, p.ctx, nullptr, nullptr, nullptr, nullptr, nullptr, ng0, mod0, mod0 + 1024, H, MT);
    grid.sync();
    run_gemm(lds, H, WABI, MT, ABIN, 1024, PX, ABIN, 1, ws);
    grid.sync();
    retention_phase(p, lds, PX, Yf, Yb);
    swa_phase(p, lds, PX, Y);
    grid.sync();
    combine_phase(Yf, Yb, PX, Y);
    grid.sync();
    run_gemm(lds, Y, WABO, MT, 1024, 1024, OX, 1024, 0, ws);
    grid.sync();
    rowwise_phase(p.x, p.ctx, p.out, CTXR, OX, ng0 + 1024, mod0 + 2 * 1024, ng0 + 2048, mod0 + 3 * 1024, mod0 + 4 * 1024, H, MT);
    grid.sync();
#define FFN0_HALF(r0) \
    run_gemm(lds, H + (size_t)(r0) * 1024, WUP, 36864, NUP, 1024, U, NUP, 0, ws); \
    grid.sync(); \
    convact_phase(U, ACT, p.ffn_conv_w, p.ffn_conv_b, (r0), 36864); \
    grid.sync(); \
    run_gemm(lds, ACT, WDN, 36864, 1024, DFF, OX + (size_t)(r0) * 1024, 1024, 0, ws);
    FFN0_HALF(0)
    FFN0_HALF(36864)
    grid.sync();
    rowwise_phase(p.out, CTXR, p.out, CTXR, OX, ng0 + 3072, mod0 + 5 * 1024, ng1, mod1, mod1 + 1024, H, MT);
    grid.sync();
    run_gemm(lds, H, WNAI, MT, NA3, 1024, PX, NA3, 2, ws);
    grid.sync();
    na_phase(p, lds, PX, Y);
    grid.sync();
    run_gemm(lds, Y, WNAO, ML, 1024, 1024, OX, 1024, 0, ws);
    grid.sync();
    rowwise_phase(p.out, CTXR, p.out, CTXR, OX, ng1 + 1024, mod1 + 2 * 1024, ng1 + 2048, mod1 + 3 * 1024, mod1 + 4 * 1024, H, ML);
    grid.sync();
#define FFN1_HALF(r0) \
    run_gemm(lds, H + (size_t)(r0) * 1024, WUP + (size_t)NUP * 1024, 32768, NUP, 1024, U, NUP, 0, ws); \
    grid.sync(); \
    convact_phase(U, ACT, p.ffn_conv_w + 3 * NUP, p.ffn_conv_b + NUP, (r0), 32768); \
    grid.sync(); \
    run_gemm(lds, ACT, WDN + (size_t)1024 * DFF, 32768, 1024, DFF, OX + (size_t)(r0) * 1024, 1024, 0, ws);
    FFN1_HALF(0)
    FFN1_HALF(32768)
    grid.sync();
    rowwise_phase(p.out, CTXR, p.out, CTXR, OX, ng1 + 3072, mod1 + 5 * 1024, nullptr, nullptr, nullptr, nullptr, ML);
}

extern "C" void kernel_launch(void* const* d_in, const int* in_sizes, int n_in, void* d_out, int out_size, void* d_ws, size_t ws_size, hipStream_t stream) {
    static int grid_blocks = 0;
    if (grid_blocks == 0) {
        if (n_in != 18 || ws_size < WS_END) { fprintf(stderr, "kernel_launch: unexpected n_in %d or ws_size %zu (need %zu)\n", n_in, ws_size, (size_t)WS_END); grid_blocks = -1; return; }
        int dev = 0, cus = 0, per_cu = 0;
        hipGetDevice(&dev);
        hipDeviceGetAttribute(&cus, hipDeviceAttributeMultiprocessorCount, dev);
        hipFuncSetAttribute((const void*)hybrid_fwd_megakernel, hipFuncAttributeMaxDynamicSharedMemorySize, LDS_BYTES);
        if (hipOccupancyMaxActiveBlocksPerMultiprocessor(&per_cu, (const void*)hybrid_fwd_megakernel, NTHREADS, LDS_BYTES) != hipSuccess || per_cu < 1) per_cu = 1;
        (void)hipGetLastError();
        grid_blocks = cus * per_cu;
    }
    if (grid_blocks < 0) return;
    Params p{};
    p.x = (const float*)d_in[0]; p.c = (const float*)d_in[1]; p.ctx = (const float*)d_in[2]; p.c_ctx = (const float*)d_in[3];
    p.w_mod = (const float*)d_in[4]; p.b_mod = (const float*)d_in[5]; p.norm_g = (const float*)d_in[6];
    p.ab_w_in = (const float*)d_in[7]; p.ab_w_out = (const float*)d_in[8]; p.ret_decay = (const float*)d_in[9]; p.swa_sink = (const float*)d_in[10];
    p.na_w_in = (const float*)d_in[11]; p.na_w_out = (const float*)d_in[12]; p.na_rpb = (const float*)d_in[13];
    p.ffn_w_up = (const float*)d_in[14]; p.ffn_conv_w = (const float*)d_in[15]; p.ffn_conv_b = (const float*)d_in[16]; p.ffn_w_down = (const float*)d_in[17];
    p.out = (float*)d_out; p.ws = (unsigned char*)d_ws;
    void* args[] = {&p};
    hipError_t e = hipLaunchCooperativeKernel((const void*)hybrid_fwd_megakernel, dim3(grid_blocks), dim3(NTHREADS), args, LDS_BYTES, stream);
    if (e != hipSuccess) fprintf(stderr, "cooperative launch failed: %s (grid %d)\n", hipGetErrorString(e), grid_blocks);
}
```

```cpp
#include <hip/hip_runtime.h>
#include <hip/hip_cooperative_groups.h>
#include <cstdio>
namespace cg = cooperative_groups;

#define LAS __attribute__((address_space(3)))
typedef unsigned short bf16_t;
typedef short bf16x8 __attribute__((ext_vector_type(8)));
typedef short s16x4 __attribute__((ext_vector_type(4)));
typedef float f32x4 __attribute__((ext_vector_type(4)));
typedef float f32x2 __attribute__((ext_vector_type(2)));
typedef unsigned u32x4 __attribute__((ext_vector_type(4)));
typedef unsigned u32x2 __attribute__((ext_vector_type(2)));

constexpr int DM = 1024, NBATCH = 32, SEQL = 2048, CTXL = 256;
constexpr int ML = NBATCH * SEQL;
constexpr int MC = NBATCH * CTXL;
constexpr int MT = ML + MC;
constexpr int ABIN = 2816, DFF = 2816, NUP = 5632, NA3 = 3072;
constexpr int NTHREADS = 512;
constexpr int LDS_BYTES = 147456;
constexpr float EPSN = 1e-6f;

constexpr size_t WS_H    = 0;
constexpr size_t WS_PX   = WS_H + (size_t)MT * 1024 * 2;
constexpr size_t WS_Y    = WS_PX + (size_t)MT * 3072 * 2;
constexpr size_t WS_OX   = WS_Y + (size_t)MT * 1024 * 2;
constexpr size_t WS_CTX  = WS_OX + (size_t)MT * 1024 * 2;
constexpr size_t WS_WABI = WS_CTX + (size_t)MC * 1024 * 4;
constexpr size_t WS_WABO = WS_WABI + (size_t)2816 * 1024 * 2;
constexpr size_t WS_WNAI = WS_WABO + (size_t)1024 * 1024 * 2;
constexpr size_t WS_WNAO = WS_WNAI + (size_t)3072 * 1024 * 2;
constexpr size_t WS_WUP  = WS_WNAO + (size_t)1024 * 1024 * 2;
constexpr size_t WS_WDN  = WS_WUP + (size_t)2 * 5632 * 1024 * 2;
constexpr size_t WS_MOD  = WS_WDN + (size_t)2 * 1024 * 2816 * 2;
constexpr size_t WS_RRET = WS_MOD + (size_t)2 * 33 * 6144 * 4;
constexpr size_t WS_R2D  = WS_RRET + (size_t)2048 * 64 * 8;
constexpr size_t WS_HALO = WS_R2D + (size_t)64 * 16 * 8;
constexpr size_t WS_BAR  = WS_HALO + (size_t)(MT / 64) * 4 * 704 * 16;
constexpr size_t WS_END  = WS_BAR + 16384;

struct Params {
    const float* x; const float* c; const float* ctx; const float* c_ctx; const float* w_mod; const float* b_mod; const float* norm_g;
    const float* ab_w_in; const float* ab_w_out; const float* ret_decay; const float* swa_sink;
    const float* na_w_in; const float* na_w_out; const float* na_rpb;
    const float* ffn_w_up; const float* ffn_conv_w; const float* ffn_conv_b; const float* ffn_w_down;
    float* out; unsigned char* ws;
};

__device__ __forceinline__ unsigned cvt_pk_bf16(float lo, float hi) { unsigned r; asm("v_cvt_pk_bf16_f32 %0, %1, %2" : "=v"(r) : "v"(lo), "v"(hi)); return r; }
__device__ __forceinline__ unsigned cvt_pk_bf16v(float lo, float hi) { unsigned r; asm volatile("v_cvt_pk_bf16_f32 %0, %1, %2" : "=v"(r) : "v"(lo), "v"(hi)); return r; }
__device__ __forceinline__ float bf_lo(unsigned u) { return __uint_as_float(u << 16); }
__device__ __forceinline__ float bf_hi(unsigned u) { return __uint_as_float(u & 0xffff0000u); }
__device__ __forceinline__ float wave_sum(float v) {
#pragma unroll
    for (int o = 32; o >= 1; o >>= 1) v += __shfl_xor(v, o);
    return v;
}
__device__ __forceinline__ unsigned off256(unsigned row, unsigned ch) { return 256u * row + 16u * (ch ^ (((row & 3u) << 2) | ((row >> 2) & 3u))); }
__device__ __forceinline__ unsigned off128(unsigned row, unsigned ch) { return 128u * row + 16u * (ch ^ (row & 7u)); }
__device__ __forceinline__ s16x4 tr_read(LAS unsigned char* p) { return __builtin_amdgcn_ds_read_tr16_b64_v4i16((LAS s16x4*)p); }
__device__ __forceinline__ bf16x8 cat4(s16x4 a, s16x4 b) { return __builtin_shufflevector(a, b, 0, 1, 2, 3, 4, 5, 6, 7); }
__device__ __forceinline__ bf16x8 pack8(f32x4 a, f32x4 b) {
    u32x4 w; w.x = cvt_pk_bf16(a[0], a[1]); w.y = cvt_pk_bf16(a[2], a[3]); w.z = cvt_pk_bf16(b[0], b[1]); w.w = cvt_pk_bf16(b[2], b[3]);
    return __builtin_bit_cast(bf16x8, w);
}
__device__ __forceinline__ bf16x8 pack8v(f32x4 a, f32x4 b) {
    u32x4 w; w.x = cvt_pk_bf16v(a[0], a[1]); w.y = cvt_pk_bf16v(a[2], a[3]); w.z = cvt_pk_bf16v(b[0], b[1]); w.w = cvt_pk_bf16v(b[2], b[3]);
    return __builtin_bit_cast(bf16x8, w);
}
#define MFMA16(a, b, c) __builtin_amdgcn_mfma_f32_16x16x32_bf16((a), (b), (c), 0, 0, 0)

#define XB_TMO      128
#define XB_XCNT(j)  (256  + 64 * (j))
#define XB_XSUB(j)  (1280 + 64 * (j))
#define XB_XGEN(j)  (2304 + 64 * (j))
#define XB_TOP      3328
#define XB_TOPGEN   3392
#define XCD_BAR_WORDS 3456
#define XB_SPIN_CAP (1u << 18)

__device__ __forceinline__ unsigned xb_ld(unsigned* p)              { return __hip_atomic_load(p, __ATOMIC_RELAXED, __HIP_MEMORY_SCOPE_AGENT); }
__device__ __forceinline__ unsigned xb_add(unsigned* p, unsigned v) { return __hip_atomic_fetch_add(p, v, __ATOMIC_RELAXED, __HIP_MEMORY_SCOPE_AGENT); }
__device__ __forceinline__ unsigned xb_xcc_id() { return (unsigned)__builtin_amdgcn_s_getreg((3 << 11) | 20) & 0xFu; }
#define XB_SPIN(cond, bar) do { unsigned _sp = 0; while (cond) { __builtin_amdgcn_s_sleep(1); \
    if ((++_sp & 255u) == 0u) { if (xb_ld(&(bar)[XB_TMO])) break; if (_sp > XB_SPIN_CAP) { atomicAdd(&(bar)[XB_TMO], 1u); break; } } } } while (0)

struct XcdBarrier {
    unsigned* bar; unsigned x;
    volatile LAS unsigned* st;
};

__device__ __forceinline__ XcdBarrier xcd_barrier_post(unsigned* bar, volatile LAS unsigned* st) {
    XcdBarrier b; b.bar = bar; b.x = xb_xcc_id(); b.st = st;
    if (threadIdx.x == 0) (void)xb_add(&bar[XB_XCNT(b.x)], 1u);
    return b;
}
__device__ __forceinline__ void xcd_barrier_complete(unsigned* bar, unsigned x, unsigned& nloc, unsigned& nx) {
    const unsigned G = gridDim.x * gridDim.y * gridDim.z;
    unsigned sum, cnt, mine, sp = 0u;
    for (;;) {
        sum = 0u; cnt = 0u; mine = 0u;
#pragma unroll
        for (unsigned j = 0; j < 16; ++j) { const unsigned c = xb_ld(&bar[XB_XCNT(j)]); sum += c; cnt += (c > 0u) ? 1u : 0u; mine = (j == x) ? c : mine; }
        if (sum == G) break;
        __builtin_amdgcn_s_sleep(1);
        if ((++sp & 255u) == 0u) { if (xb_ld(&bar[XB_TMO])) break; if (sp > XB_SPIN_CAP) { atomicAdd(&bar[XB_TMO], 1u); break; } }
    }
    nloc = mine > 0u ? mine : 1u; nx = cnt > 0u ? cnt : 1u;
}

__device__ __forceinline__ void xcd_barrier(const XcdBarrier& b) {
    asm volatile("s_waitcnt vmcnt(0)" ::: "memory");
    __syncthreads();
    if (threadIdx.x == 0) {
        unsigned* bar = b.bar;
        __builtin_amdgcn_s_waitcnt(0);
        unsigned nloc = b.st[0], nx = b.st[1];
        if (nloc == 0u) { xcd_barrier_complete(bar, b.x, nloc, nx); b.st[0] = nloc; b.st[1] = nx; }
        const unsigned old = xb_add(&bar[XB_XSUB(b.x)], 1u);
        const unsigned gen = old / nloc;
        if (old + 1u == (gen + 1u) * nloc) {
            __builtin_amdgcn_fence(__ATOMIC_RELEASE, "agent");
            asm volatile("s_waitcnt vmcnt(0)" ::: "memory");
            const unsigned og = xb_add(&bar[XB_TOP], 1u);
            const unsigned tg = og / nx;
            if (og + 1u == (tg + 1u) * nx) xb_add(&bar[XB_TOPGEN], 1u);
            else XB_SPIN(xb_ld(&bar[XB_TOPGEN]) == tg, bar);
            __builtin_amdgcn_fence(__ATOMIC_ACQUIRE, "agent");
            xb_add(&bar[XB_XGEN(b.x)], 1u);
            asm volatile("s_waitcnt vmcnt(0)" ::: "memory");
        } else {
            XB_SPIN(xb_ld(&bar[XB_XGEN(b.x)]) == gen, bar);
            __builtin_amdgcn_fence(__ATOMIC_ACQUIRE, "agent");
            asm volatile("s_waitcnt vmcnt(0)" ::: "memory");
        }
    }
    __syncthreads();
}

namespace pg8 {
#define PG8_LAS __attribute__((address_space(3)))
typedef unsigned short bf16_t;
typedef short bf16x8 __attribute__((ext_vector_type(8)));
typedef float f32x4 __attribute__((ext_vector_type(4)));
typedef unsigned u32x4 __attribute__((ext_vector_type(4)));
constexpr int BM = 256, BK = 64, HALF = 128, HTB = HALF * BK * 2  , STAGE_BYTES = 8 * HTB, NXCD = 8, WGM = 8;

__host__ __device__ __forceinline__ int lds_byte(int r, int c) { const int st = (r >> 4) * 2 + (c >> 5), rr = r & 15, cc = c & 31, ob = rr * 64 + cc * 2; return st * 1024 + (ob ^ (((ob >> 9) & 1) << 5)); }
__host__ __device__ __forceinline__ void stage_rc(int b, int& R, int& C) { const int st = b / 1024, sb = b % 1024, swz = sb ^ (((sb >> 9) & 1) << 5); R = (st >> 1) * 16 + swz / 64; C = (st & 1) * 32 + (swz % 64) / 2; }
__host__ __device__ __forceinline__ int perm32(int rho) { const int n = rho >> 4, i = rho & 15; return 8 * (i >> 2) + 4 * n + (i & 3); }

struct Unit { int pm, pn; };
struct Gemm { const bf16_t* A; const bf16_t* Bt; int M, N, K; };

struct StaticOrder {
    int nM, nN, nwg, G, c;
    __host__ __device__ void init(int M, int N, int G_, int c_) { nM = M / BM; nN = N / BM; nwg = nM * nN; G = G_; c = c_; }
    __host__ __device__ bool next(int i, Unit& u) const {
        const long L = (long)i * G + c; if (L >= nwg) return false;
        int wgid = (int)L; { const int q = nwg / NXCD, r = nwg % NXCD, xcd = wgid % NXCD, off = wgid / NXCD; wgid = (xcd < r ? xcd * (q + 1) : r * (q + 1) + (xcd - r) * q) + off; }
        const int nig = WGM * nN, gid = wgid / nig, fm = gid * WGM, gsz = (nM - fm) < WGM ? (nM - fm) : WGM;
        u.pm = fm + ((wgid % nig) % gsz); u.pn = (wgid % nig) / gsz; return true;
    }
    __device__ __forceinline__ void a_ready(const Unit&) const {}
    __device__ __forceinline__ void done(const Unit&) const {}
};

__device__ __forceinline__ unsigned cvt_pk_bf16(float lo, float hi) { unsigned r; asm("v_cvt_pk_bf16_f32 %0, %1, %2" : "=v"(r) : "v"(lo), "v"(hi)); return r; }
struct EpiOut {
    static constexpr bool PERM = true, AFTER_DRAIN = false;
    bf16_t* O; int ldc; int mode;
    const f32x4* rret; const f32x4* r2d;
    __device__ __forceinline__ void operator()(const f32x4 (&acc)[2][2][4][2], const Unit& u, int wr, int wc, int fr, int fq) const {
        const int row0 = u.pm * BM + wr * 64 + fr;
        const int colw = wc * 32 + 8 * fq;
        const bool lat = (u.pm < 256);
#pragma unroll
        for (int bj = 0; bj < 2; ++bj) {
            const int colbase = u.pn * BM + bj * HALF;
            const int col0 = colbase + colw;
            int kind = 0; float scale = 1.f;
            if (mode == 1) {
                if (colbase < 512) { kind = 1; }
                else if (colbase < 1024) { kind = 1; scale = 0.08838834764831845f; }
                else if (colbase < 2048) { }
                else if (colbase < 2560) { kind = 2; scale = 0.18033688011112042f; }
                else if (colbase < 2688) { kind = 2; }
            } else if (mode == 2) { if (colbase < 1024) scale = 0.18033688011112042f; }
            if (!lat) kind = 0;
#pragma unroll
            for (int ai = 0; ai < 2; ++ai)
#pragma unroll
                for (int m = 0; m < 4; ++m) {
                    const int row = row0 + ai * HALF + m * 16;
                    f32x4 v0 = acc[ai][bj][m][0] * scale, v1 = acc[ai][bj][m][1] * scale;
                    if (kind != 0) {
                        const int t = row & 2047;
                        const f32x4* tp;
                        if (kind == 1) tp = rret + ((t * 64 + ((col0 & 127) >> 1)) >> 1);
                        else { const int i0 = (col0 & 63) >> 1; const int pos = i0 < 16 ? (t >> 6) : (t & 63); tp = r2d + ((pos * 16 + (i0 & 15)) >> 1); }
                        const f32x4 cs0 = tp[0], cs1 = tp[1];
                        float a, b;
                        a = v0[0]; b = v0[1]; v0[0] = a * cs0[0] - b * cs0[1]; v0[1] = a * cs0[1] + b * cs0[0];
                        a = v0[2]; b = v0[3]; v0[2] = a * cs0[2] - b * cs0[3]; v0[3] = a * cs0[3] + b * cs0[2];
                        a = v1[0]; b = v1[1]; v1[0] = a * cs1[0] - b * cs1[1]; v1[1] = a * cs1[1] + b * cs1[0];
                        a = v1[2]; b = v1[3]; v1[2] = a * cs1[2] - b * cs1[3]; v1[3] = a * cs1[3] + b * cs1[2];
                    }
                    u32x4 w; w.x = cvt_pk_bf16(v0[0], v0[1]); w.y = cvt_pk_bf16(v0[2], v0[3]); w.z = cvt_pk_bf16(v1[0], v1[1]); w.w = cvt_pk_bf16(v1[2], v1[3]);
                    *(u32x4*)(O + (size_t)row * ldc + col0) = w;
                }
        }
    }
};


__device__ __forceinline__ float bfl(unsigned u) { return __uint_as_float(u << 16); }
__device__ __forceinline__ float bfh(unsigned u) { return __uint_as_float(u & 0xffff0000u); }
__device__ __forceinline__ float silu1(float x) { return x * __builtin_amdgcn_rcpf(1.0f + __expf(-x)); }
struct ConvW { f32x4 wa0, wa1, wa2, ba, wg0, wg1, wg2, bg; };
__device__ __forceinline__ ConvW load_convw(const float* cw, const float* cb, int q) {
    ConvW w;
    w.wa0 = *(const f32x4*)(cw + 4 * q); w.wa1 = *(const f32x4*)(cw + 5632 + 4 * q); w.wa2 = *(const f32x4*)(cw + 2 * 5632 + 4 * q); w.ba = *(const f32x4*)(cb + 4 * q);
    w.wg0 = *(const f32x4*)(cw + 2816 + 4 * q); w.wg1 = *(const f32x4*)(cw + 5632 + 2816 + 4 * q); w.wg2 = *(const f32x4*)(cw + 2 * 5632 + 2816 + 4 * q); w.bg = *(const f32x4*)(cb + 2816 + 4 * q);
    return w;
}
typedef unsigned u32x2e __attribute__((ext_vector_type(2)));
__device__ __forceinline__ u32x2e conv_act(const ConvW& w, u32x4 pv, u32x4 cv, u32x4 nv) {
    const f32x4 ap = (f32x4){bfl(pv.x), bfh(pv.x), bfl(pv.y), bfh(pv.y)}, gp = (f32x4){bfl(pv.z), bfh(pv.z), bfl(pv.w), bfh(pv.w)};
    const f32x4 ac = (f32x4){bfl(cv.x), bfh(cv.x), bfl(cv.y), bfh(cv.y)}, gc = (f32x4){bfl(cv.z), bfh(cv.z), bfl(cv.w), bfh(cv.w)};
    const f32x4 an = (f32x4){bfl(nv.x), bfh(nv.x), bfl(nv.y), bfh(nv.y)}, gn = (f32x4){bfl(nv.z), bfh(nv.z), bfl(nv.w), bfh(nv.w)};
    const f32x4 a = w.ba + w.wa0 * ap + w.wa1 * ac + w.wa2 * an;
    const f32x4 g = w.bg + w.wg0 * gp + w.wg1 * gc + w.wg2 * gn;
    u32x2e r; r.x = cvt_pk_bf16(silu1(g[0]) * a[0], silu1(g[1]) * a[1]); r.y = cvt_pk_bf16(silu1(g[2]) * a[2], silu1(g[3]) * a[3]);
    return r;
}
struct EpiConv {
    static constexpr bool PERM = true, AFTER_DRAIN = false;
    bf16_t* ACT; u32x4* HALO; const float* cw; const float* cb;
    __device__ __forceinline__ void operator()(const f32x4 (&acc)[2][2][4][2], const Unit& u, int wr, int wc, int fr, int fq) const {
        const int lane = fq * 16 + fr;
        const int src_prev = (lane & 48) | ((fr + 15) & 15), src_next = (lane & 48) | ((fr + 1) & 15);
#pragma unroll
        for (int bj = 0; bj < 2; ++bj) {
            const int q = u.pn * 32 + bj * 16 + wc * 4 + fq;
            const ConvW w = load_convw(cw, cb, q);
#pragma unroll
            for (int ai = 0; ai < 2; ++ai) {
                const int rowb = u.pm * BM + ai * HALF + wr * 64;
                u32x4 P[4];
#pragma unroll
                for (int m = 0; m < 4; ++m) {
                    P[m].x = cvt_pk_bf16(acc[ai][bj][m][0][0], acc[ai][bj][m][0][1]); P[m].y = cvt_pk_bf16(acc[ai][bj][m][0][2], acc[ai][bj][m][0][3]);
                    P[m].z = cvt_pk_bf16(acc[ai][bj][m][1][0], acc[ai][bj][m][1][1]); P[m].w = cvt_pk_bf16(acc[ai][bj][m][1][2], acc[ai][bj][m][1][3]);
                }
#pragma unroll
                for (int m = 0; m < 4; ++m) {
                    const u32x4 sp = (m > 0 && fr == 15) ? P[m > 0 ? m - 1 : 0] : P[m];
                    const u32x4 sn = (m < 3 && fr == 0) ? P[m < 3 ? m + 1 : 3] : P[m];
                    u32x4 pv, nv;
                    pv.x = (unsigned)__shfl((int)sp.x, src_prev); pv.y = (unsigned)__shfl((int)sp.y, src_prev); pv.z = (unsigned)__shfl((int)sp.z, src_prev); pv.w = (unsigned)__shfl((int)sp.w, src_prev);
                    nv.x = (unsigned)__shfl((int)sn.x, src_next); nv.y = (unsigned)__shfl((int)sn.y, src_next); nv.z = (unsigned)__shfl((int)sn.z, src_next); nv.w = (unsigned)__shfl((int)sn.w, src_next);
                    const int rl = 16 * m + fr;
                    const u32x2e r = conv_act(w, pv, P[m], nv);
                    if (rl != 0 && rl != 63) *(u32x2e*)(ACT + (size_t)(rowb + rl) * 2816 + 4 * q) = r;
                    if (rl < 2 || rl >= 62) HALO[(size_t)((rowb >> 6) * 4 + (rl < 2 ? rl : rl - 60)) * 704 + q] = P[m];
                }
            }
        }
    }
};

template <class Epi, class Sched, bool STAMP = false>
__device__ __forceinline__ void gemm_phase(PG8_LAS unsigned char* lds, const Gemm g, const Sched& S, const Epi& E, unsigned long long* stamps) {
    int tid_l = threadIdx.x; asm volatile("" : "+v"(tid_l));
    const int tid = tid_l, wid = __builtin_amdgcn_readfirstlane(tid >> 6), lane = tid & 63, wr = wid >> 2, wc = wid & 3, fr = lane & 15, fq = lane >> 4;
    const int K = g.K, nt = K / BK;
    int ts_lo = 0, ts_hi = 0, nts = 0; const unsigned long long rt_entry = STAMP ? (unsigned long long)wall_clock64() : 0ull;
#define PG8_STAMP() do { if (STAMP && wid == 0 && nts < 64) { const unsigned long long _c = (unsigned long long)clock64(); \
        ts_lo = (lane == nts) ? (int)(unsigned)_c : ts_lo; ts_hi = (lane == nts) ? (int)(unsigned)(_c >> 32) : ts_hi; ++nts; } } while (0)
    PG8_STAMP();
    unsigned voffA[2], voffB[2];
#pragma unroll
    for (int i = 0; i < 2; ++i) { int R, C; stage_rc(tid * 16 + i * 8192, R, C); const int Rb = Epi::PERM ? ((R & ~31) + perm32(R & 31)) : R;
        voffA[i] = (unsigned)(R * K + C) * 2u; voffB[i] = (unsigned)(Rb * K + C) * 2u; }
    const size_t kstep = (size_t)(BK * 2);
    const size_t hstep = (size_t)HALF * K * 2;
    const size_t tstep = 2 * hstep;
    const unsigned ldsw = (unsigned)wid * 1024u;
    const int aoff = lds_byte(wr * 64 + fr, fq * 8), boff = lds_byte(wc * 32 + fr, fq * 8);
#define PG8_SA(b, h) (((b) * 2 + (h)) * HTB)
#define PG8_SB(b, h) ((4 + (b) * 2 + (h)) * HTB)
#define PG8_STAGE(bufoff, gbase, voff) do { _Pragma("unroll") for (int _i = 0; _i < 2; ++_i) \
        __builtin_amdgcn_global_load_lds((const unsigned*)((const char*)(gbase) + (voff)[_i]), (PG8_LAS unsigned*)(lds + (bufoff) + ldsw + _i * 8192), 16, 0, 0); } while (0)
#define PG8_LDA(dst, b, h) do { _Pragma("unroll") for (int m = 0; m < 4; ++m) _Pragma("unroll") for (int k = 0; k < 2; ++k) dst[m][k] = *(const PG8_LAS bf16x8*)(lds + PG8_SA(b, h) + aoff + m * 2048 + k * 1024); } while (0)
#define PG8_LDB(dst, b, h) do { _Pragma("unroll") for (int n = 0; n < 2; ++n) _Pragma("unroll") for (int k = 0; k < 2; ++k) dst[n][k] = *(const PG8_LAS bf16x8*)(lds + PG8_SB(b, h) + boff + n * 2048 + k * 1024); } while (0)
#define PG8_MMA(ai, bj, At, Bt) do { __builtin_amdgcn_s_setprio(1); _Pragma("unroll") for (int m = 0; m < 4; ++m) _Pragma("unroll") for (int n = 0; n < 2; ++n) _Pragma("unroll") for (int k = 0; k < 2; ++k) \
        acc[ai][bj][m][n] = __builtin_amdgcn_mfma_f32_16x16x32_bf16(Bt[n][k], At[m][k], acc[ai][bj][m][n], 0, 0, 0); __builtin_amdgcn_s_setprio(0); } while (0)
#define PG8_WAIT_V(n) asm volatile("s_waitcnt vmcnt(" #n ")" ::: "memory")
#define PG8_WAIT_L(n) asm volatile("s_waitcnt lgkmcnt(" #n ")" ::: "memory")
#define PG8_BAR __builtin_amdgcn_s_barrier()
#define PG8_SCHED __builtin_amdgcn_sched_barrier(0)
    Unit cur, nxt; int ui = 0;
    if (!S.next(0, cur)) return;
    f32x4 acc[2][2][4][2];
#pragma unroll
    for (int a = 0; a < 2; ++a)
#pragma unroll
        for (int b = 0; b < 2; ++b)
#pragma unroll
            for (int m = 0; m < 4; ++m)
#pragma unroll
                for (int n = 0; n < 2; ++n) acc[a][b][m][n] = (f32x4){0.f, 0.f, 0.f, 0.f};
    bf16x8 At[4][2], B0[2][2], B1[2][2];
    const char* cA = (const char*)g.A + (size_t)cur.pm * tstep; const char* cB = (const char*)g.Bt + (size_t)cur.pn * tstep;
    S.a_ready(cur);
    PG8_STAGE(PG8_SB(0, 0), cB, voffB); PG8_STAGE(PG8_SA(0, 0), cA, voffA); PG8_STAGE(PG8_SB(0, 1), cB + hstep, voffB); PG8_STAGE(PG8_SA(0, 1), cA + hstep, voffA);
    if (wr == 1) PG8_BAR;
    PG8_WAIT_V(4); PG8_BAR;
    PG8_STAGE(PG8_SB(1, 0), cB + kstep, voffB); PG8_STAGE(PG8_SA(1, 0), cA + kstep, voffA); PG8_STAGE(PG8_SB(1, 1), cB + hstep + kstep, voffB);
    PG8_WAIT_V(6); PG8_BAR;
    PG8_STAMP();
    for (;;) {
        const bool has_next = S.next(ui + 1, nxt);
        const char* nA = has_next ? (const char*)g.A + (size_t)nxt.pm * tstep : cA; const char* nB = has_next ? (const char*)g.Bt + (size_t)nxt.pn * tstep : cB;
        for (int t = 0; t < nt; t += 2) {
            const bool last = (t == nt - 2);
            const char* a1 = cA + (size_t)(t + 1) * kstep;
            const char* a2 = last ? nA : cA + (size_t)(t + 2) * kstep; const char* b2 = last ? nB : cB + (size_t)(t + 2) * kstep;
            const char* a3 = a2 + kstep; const char* b3 = b2 + kstep;
            if (last && has_next) S.a_ready(nxt);
            PG8_LDB(B0, 0, 0); PG8_SCHED; PG8_LDA(At, 0, 0); PG8_STAGE(PG8_SA(1, 1), a1 + hstep, voffA);
            PG8_WAIT_L(8); PG8_BAR; PG8_WAIT_L(0); PG8_MMA(0, 0, At, B0); PG8_BAR; PG8_SCHED;
            PG8_LDB(B1, 0, 1); PG8_STAGE(PG8_SB(0, 0), b2, voffB);
            PG8_BAR; PG8_WAIT_L(0); PG8_MMA(0, 1, At, B1); PG8_BAR;
            PG8_LDA(At, 0, 1); PG8_STAGE(PG8_SA(0, 0), a2, voffA);
            PG8_BAR; PG8_WAIT_L(0); PG8_MMA(1, 0, At, B0); PG8_BAR; PG8_SCHED;
            PG8_STAGE(PG8_SB(0, 1), b2 + hstep, voffB);
            PG8_WAIT_V(6); PG8_BAR; PG8_MMA(1, 1, At, B1); PG8_BAR;
            PG8_LDB(B0, 1, 0); PG8_SCHED; PG8_LDA(At, 1, 0); PG8_STAGE(PG8_SA(0, 1), a2 + hstep, voffA);
            PG8_WAIT_L(8); PG8_BAR; PG8_WAIT_L(0); PG8_MMA(0, 0, At, B0); PG8_BAR; PG8_SCHED;
            PG8_LDB(B1, 1, 1); PG8_STAGE(PG8_SB(1, 0), b3, voffB);
            PG8_BAR; PG8_WAIT_L(0); PG8_MMA(0, 1, At, B1); PG8_BAR;
            PG8_LDA(At, 1, 1); PG8_STAGE(PG8_SA(1, 0), a3, voffA);
            PG8_BAR; PG8_WAIT_L(0); PG8_MMA(1, 0, At, B0); PG8_BAR; PG8_SCHED;
            PG8_STAGE(PG8_SB(1, 1), b3 + hstep, voffB);
            PG8_WAIT_V(6); PG8_BAR; PG8_MMA(1, 1, At, B1); PG8_BAR;
        }
        PG8_STAMP();
        if constexpr (!Epi::AFTER_DRAIN) { E(acc, cur, wr, wc, fr, fq); S.done(cur); }
        PG8_STAMP();
        if (!has_next) break;
#pragma unroll
        for (int a = 0; a < 2; ++a)
#pragma unroll
            for (int b = 0; b < 2; ++b)
#pragma unroll
                for (int m = 0; m < 4; ++m)
#pragma unroll
                    for (int n = 0; n < 2; ++n) acc[a][b][m][n] = (f32x4){0.f, 0.f, 0.f, 0.f};
        cur = nxt; cA = nA; cB = nB; ++ui;
    }
    PG8_WAIT_V(0);
    if (wr == 0) PG8_BAR;
    PG8_BAR;
    if constexpr (Epi::AFTER_DRAIN) { E.fused(acc, cur, wr, wc, fr, fq, lds, wid, lane); S.done(cur); }
    PG8_STAMP();
    if (STAMP && wid == 0) { stamps[lane] = lane < nts ? (((unsigned long long)(unsigned)ts_hi << 32) | (unsigned)ts_lo) : 0ull;
        if (lane == 62) stamps[62] = rt_entry; if (lane == 63) stamps[63] = (unsigned long long)wall_clock64(); }
#undef PG8_STAMP
#undef PG8_SA
#undef PG8_SB
#undef PG8_STAGE
#undef PG8_LDA
#undef PG8_LDB
#undef PG8_MMA
#undef PG8_WAIT_V
#undef PG8_WAIT_L
#undef PG8_BAR
#undef PG8_SCHED
}
}

__device__ __forceinline__ int tid_fresh() { int t = threadIdx.x; asm volatile("" : "+v"(t)); return t; }
__device__ __forceinline__ int perm_ab(int p) {
    if (p < 1024) { const int h = p >> 7, q = p & 127; return (h << 7) + (q >> 1) + ((q & 1) << 6); }
    if (p < 2048) return p;
    if (p < 2688) { const int hb = p & ~63, q = p & 63, i = q >> 1; return hb + (i < 16 ? i : 16 + i) + ((q & 1) << 4); }
    return p;
}
__device__ __forceinline__ int perm_up(int p) { const int q = p >> 3, e = p & 7; return e < 4 ? 4 * q + e : DFF + 4 * q + (e - 4); }

struct TrJob { const float* W; bf16_t* Wt; int K, N, ptype, tile; };
__device__ __forceinline__ TrJob tr_job(const Params& p, unsigned char* ws, int t) {
    TrJob j;
    if (t < 704) { j.W = p.ab_w_in; j.K = 1024; j.N = 2816; j.Wt = (bf16_t*)(ws + WS_WABI); j.ptype = 1; j.tile = t; }
    else if (t < 960) { j.W = p.ab_w_out; j.K = 1024; j.N = 1024; j.Wt = (bf16_t*)(ws + WS_WABO); j.ptype = 0; j.tile = t - 704; }
    else if (t < 1728) { j.W = p.na_w_in; j.K = 1024; j.N = 3072; j.Wt = (bf16_t*)(ws + WS_WNAI); j.ptype = 0; j.tile = t - 960; }
    else if (t < 1984) { j.W = p.na_w_out; j.K = 1024; j.N = 1024; j.Wt = (bf16_t*)(ws + WS_WNAO); j.ptype = 0; j.tile = t - 1728; }
    else if (t < 3392) { j.W = p.ffn_w_up; j.K = 1024; j.N = 5632; j.Wt = (bf16_t*)(ws + WS_WUP); j.ptype = 2; j.tile = t - 1984; }
    else if (t < 4800) { j.W = p.ffn_w_up + (size_t)1024 * 5632; j.K = 1024; j.N = 5632; j.Wt = (bf16_t*)(ws + WS_WUP) + (size_t)5632 * 1024; j.ptype = 2; j.tile = t - 3392; }
    else if (t < 5504) { j.W = p.ffn_w_down; j.K = 2816; j.N = 1024; j.Wt = (bf16_t*)(ws + WS_WDN); j.ptype = 0; j.tile = t - 4800; }
    else { j.W = p.ffn_w_down + (size_t)2816 * 1024; j.K = 2816; j.N = 1024; j.Wt = (bf16_t*)(ws + WS_WDN) + (size_t)1024 * 2816; j.ptype = 0; j.tile = t - 5504; }
    return j;
}
__device__ __forceinline__ void tr_load(const TrJob& j, int tid, float (&v)[8]) {
    const int ntn = j.N >> 6;
    const int tk = j.tile / ntn, tn = j.tile - tk * ntn;
    const int jj = tid & 63, i0 = tid >> 6, n = tn * 64 + jj;
    const int ncol = j.ptype == 1 ? perm_ab(n) : (j.ptype == 2 ? perm_up(n) : n);
    const float* src = j.W + (size_t)(tk * 64 + i0) * j.N + ncol;
#pragma unroll
    for (int ii = 0; ii < 8; ++ii) v[ii] = src[(size_t)(8 * ii) * j.N];
}
__device__ __forceinline__ void tr_store(const TrJob& j, int tid, const float (&v)[8], LAS float* T) {
    const int ntn = j.N >> 6;
    const int tk = j.tile / ntn, tn = j.tile - tk * ntn;
    {
        const int jj = tid & 63, i0 = tid >> 6;
#pragma unroll
        for (int ii = 0; ii < 8; ++ii) T[jj * 65 + i0 + 8 * ii] = v[ii];
    }
    __syncthreads();
    {
        const int r = tid >> 3, c = tid & 7;
        LAS float* s = T + r * 65 + c * 8;
        u32x4 w; w.x = cvt_pk_bf16(s[0], s[1]); w.y = cvt_pk_bf16(s[2], s[3]); w.z = cvt_pk_bf16(s[4], s[5]); w.w = cvt_pk_bf16(s[6], s[7]);
        *(u32x4*)(j.Wt + (size_t)(tn * 64 + r) * j.K + tk * 64 + c * 8) = w;
    }
    __syncthreads();
}

__device__ __forceinline__ void prep_phase(const Params& p, LAS unsigned char* lds) {
    unsigned char* ws = p.ws;
    const int tid = tid_fresh(), lane = tid & 63, w = tid >> 6;
    {
        f32x2* rret = (f32x2*)(ws + WS_RRET); f32x2* r2d = (f32x2*)(ws + WS_R2D);
        for (int idx = blockIdx.x * NTHREADS + tid; idx < 2048 * 64 + 64 * 16; idx += gridDim.x * NTHREADS) {
            if (idx < 2048 * 64) { const int t = idx >> 6, i = idx & 63; const float inv = powf(10000.0f, -(float)i / 64.0f); const float ang = (float)t * inv; f32x2 v; v.x = cosf(ang); v.y = sinf(ang); rret[idx] = v; }
            else { const int j = idx - 2048 * 64, pos = j >> 4, i = j & 15; const float inv = powf(10000.0f, -(float)i / 16.0f); const float ang = (float)pos * inv; f32x2 v; v.x = cosf(ang); v.y = sinf(ang); r2d[j] = v; }
        }
    }
    {
        LAS float* sil = (LAS float*)lds;
        float* mod = (float*)(ws + WS_MOD);
        for (int it = (int)gridDim.x - 1 - (int)blockIdx.x; it < 192; it += gridDim.x) {
            __syncthreads();
            for (int idx = tid; idx < 33 * 1024; idx += NTHREADS) { const float v = idx < 32 * 1024 ? p.c[idx] : p.c_ctx[idx - 32 * 1024]; sil[idx] = v / (1.0f + expf(-v)); }
            __syncthreads();
            const int l = it / 96, col0 = (it % 96) * 64;
            const float* wm = p.w_mod + (size_t)l * 1024 * 6144 + col0 + lane;
            float acc[33];
#pragma unroll
            for (int r = 0; r < 33; ++r) acc[r] = 0.f;
            float wn[8];
#pragma unroll
            for (int u = 0; u < 8; ++u) wn[u] = wm[(size_t)(w * 128 + u) * 6144];
            for (int k0 = w * 128; k0 < w * 128 + 128; k0 += 8) {
                float wv[8];
#pragma unroll
                for (int u = 0; u < 8; ++u) wv[u] = wn[u];
                if (k0 + 8 < w * 128 + 128) {
#pragma unroll
                    for (int u = 0; u < 8; ++u) wn[u] = wm[(size_t)(k0 + 8 + u) * 6144];
                }
#pragma unroll
                for (int r = 0; r < 33; ++r) {
                    const f32x4 s0 = *(LAS f32x4*)(sil + r * 1024 + k0), s1 = *(LAS f32x4*)(sil + r * 1024 + k0 + 4);
                    acc[r] += s0[0] * wv[0] + s0[1] * wv[1] + s0[2] * wv[2] + s0[3] * wv[3] + s1[0] * wv[4] + s1[1] * wv[5] + s1[2] * wv[6] + s1[3] * wv[7];
                }
            }
            __syncthreads();
            LAS float* red = (LAS float*)lds;
#pragma unroll
            for (int r = 0; r < 33; ++r) red[(w * 33 + r) * 64 + lane] = acc[r];
            __syncthreads();
            for (int idx = tid; idx < 33 * 64; idx += NTHREADS) {
                const int r = idx >> 6, cc = idx & 63;
                float s = p.b_mod[l * 6144 + col0 + cc];
#pragma unroll
                for (int ww = 0; ww < 8; ++ww) s += red[(ww * 33 + r) * 64 + cc];
                mod[(size_t)(l * 33 + r) * 6144 + col0 + cc] = s;
            }
        }
        __syncthreads();
    }
    {
        LAS float* T = (LAS float*)lds;
        const int G = (int)gridDim.x;
        int t = blockIdx.x;
        if (t < 6208) {
            float curA[8], curB[8], nxtA[8], nxtB[8];
            TrJob jA = tr_job(p, ws, t), jB = jA;
            bool hasB = t + G < 6208;
            tr_load(jA, tid, curA);
            if (hasB) { jB = tr_job(p, ws, t + G); tr_load(jB, tid, curB); }
            for (;;) {
                const int tnA = t + 2 * G, tnB = t + 3 * G;
                const bool nA = tnA < 6208, nB = tnB < 6208;
                TrJob jnA = jA, jnB = jB;
                if (nA) { jnA = tr_job(p, ws, tnA); tr_load(jnA, tid, nxtA); }
                if (nB) { jnB = tr_job(p, ws, tnB); tr_load(jnB, tid, nxtB); }
                tr_store(jA, tid, curA, T);
                if (hasB) tr_store(jB, tid, curB, T);
                if (!nA) break;
#pragma unroll
                for (int i = 0; i < 8; ++i) { curA[i] = nxtA[i]; curB[i] = nxtB[i]; }
                jA = jnA; jB = jnB; hasB = nB; t = tnA;
            }
        }
    }
}

__device__ __forceinline__ void rowwise_phase(const float* xin_lat, const float* xin_ctx, float* xout_lat, float* xout_ctx, const bf16_t* ox,
                                           const float* gpost, const float* modgate, const float* gpre, const float* modshift, const float* modscale, bf16_t* H, int nrows) {
    const int tid = tid_fresh(), lane = tid & 63, gw = blockIdx.x * 8 + (tid >> 6), nw = gridDim.x * 8;
    for (int grp = gw; grp * 4 < nrows; grp += nw) {
        const int rowb = grp * 4;
        const bool lat = rowb < ML; const int mrow = lat ? (rowb >> 11) : 32;
        const float* xi = lat ? xin_lat + (size_t)rowb * 1024 : xin_ctx + (size_t)(rowb - ML) * 1024;
        f32x4 v[4][4]; u32x2 ob[4][4];
#pragma unroll
        for (int u = 0; u < 4; ++u) {
#pragma unroll
            for (int i = 0; i < 4; ++i) v[u][i] = __builtin_nontemporal_load((const f32x4*)(xi + u * 1024 + lane * 4 + 256 * i));
            if (ox) {
#pragma unroll
                for (int i = 0; i < 4; ++i) ob[u][i] = *(const u32x2*)(ox + (size_t)(rowb + u) * 1024 + lane * 4 + 256 * i);
            }
        }
        if (ox) {
            f32x4 gg[4];
            const float* gate = modgate + (size_t)mrow * 6144;
#pragma unroll
            for (int i = 0; i < 4; ++i) { const int col = lane * 4 + 256 * i; gg[i] = *(const f32x4*)(gpost + col) * *(const f32x4*)(gate + col); }
            float* xo = lat ? xout_lat + (size_t)rowb * 1024 : xout_ctx + (size_t)(rowb - ML) * 1024;
#pragma unroll
            for (int u = 0; u < 4; ++u) {
                f32x4 o[4]; float ss = 0.f;
#pragma unroll
                for (int i = 0; i < 4; ++i) {
                    const u32x2 t = ob[u][i];
                    o[i] = (f32x4){bf_lo(t.x), bf_hi(t.x), bf_lo(t.y), bf_hi(t.y)};
                    ss += o[i][0] * o[i][0] + o[i][1] * o[i][1] + o[i][2] * o[i][2] + o[i][3] * o[i][3];
                }
                ss = wave_sum(ss);
                const float rinv = rsqrtf(ss * (1.0f / 1024.0f) + EPSN);
#pragma unroll
                for (int i = 0; i < 4; ++i) {
                    v[u][i] += (o[i] * rinv) * gg[i];
                    __builtin_nontemporal_store(v[u][i], (f32x4*)(xo + u * 1024 + lane * 4 + 256 * i));
                }
            }
        }
        if (H) {
            f32x4 g2[4], s1[4], s0[4];
            const float* sh = modshift + (size_t)mrow * 6144; const float* sc = modscale + (size_t)mrow * 6144;
#pragma unroll
            for (int i = 0; i < 4; ++i) { const int col = lane * 4 + 256 * i; s1[i] = *(const f32x4*)(sc + col) + 1.0f; g2[i] = *(const f32x4*)(gpre + col) * s1[i]; s0[i] = *(const f32x4*)(sh + col); }
#pragma unroll
            for (int u = 0; u < 4; ++u) {
                float ss = 0.f;
#pragma unroll
                for (int i = 0; i < 4; ++i) ss += v[u][i][0] * v[u][i][0] + v[u][i][1] * v[u][i][1] + v[u][i][2] * v[u][i][2] + v[u][i][3] * v[u][i][3];
                ss = wave_sum(ss);
                const float rinv = rsqrtf(ss * (1.0f / 1024.0f) + EPSN);
#pragma unroll
                for (int i = 0; i < 4; ++i) {
                    const f32x4 h = (v[u][i] * rinv) * g2[i] + s0[i];
                    u32x2 wv; wv.x = cvt_pk_bf16(h[0], h[1]); wv.y = cvt_pk_bf16(h[2], h[3]);
                    *(u32x2*)(H + (size_t)(rowb + u) * 1024 + lane * 4 + 256 * i) = wv;
                }
            }
        }
    }
}

__device__ __forceinline__ float silu_f(float x) { return x * __builtin_amdgcn_rcpf(1.0f + __expf(-x)); }
__device__ __forceinline__ void convact_phase(const bf16_t* U, bf16_t* ACT, const float* cw, const float* cb, int row0g, int nrows) {
    const int tid = tid_fresh(), lane = tid & 63, gw = blockIdx.x * 8 + (tid >> 6), nw = gridDim.x * 8;
    const int nitems = (nrows >> 5) * 11;
    for (int it = gw; it < nitems; it += nw) {
        const int slab = it % 11, rb = it / 11;
        const int q = slab * 64 + lane;
        const f32x4 wa0 = *(const f32x4*)(cw + 4 * q), wa1 = *(const f32x4*)(cw + NUP + 4 * q), wa2 = *(const f32x4*)(cw + 2 * NUP + 4 * q), ba = *(const f32x4*)(cb + 4 * q);
        const f32x4 wg0 = *(const f32x4*)(cw + DFF + 4 * q), wg1 = *(const f32x4*)(cw + NUP + DFF + 4 * q), wg2 = *(const f32x4*)(cw + 2 * NUP + DFF + 4 * q), bg = *(const f32x4*)(cb + DFF + 4 * q);
        const int r0 = rb * 32, R0 = row0g + r0;
        const int pos0 = R0 < ML ? (R0 & 2047) : ((R0 - ML) & 255), len = R0 < ML ? 2048 : 256;
        const bf16_t* up = U + (size_t)r0 * NUP + 8 * q;
        const u32x4 zero = (u32x4){0u, 0u, 0u, 0u};
        u32x4 prev = zero, cur;
        if (pos0 > 0) prev = *(const u32x4*)(up - NUP);
        cur = *(const u32x4*)(up);
        for (int g8 = 0; g8 < 4; ++g8) {
            u32x4 nx[8];
#pragma unroll
            for (int j = 0; j < 8; ++j) { const int rr = g8 * 8 + j; nx[j] = zero; if (pos0 + rr + 1 < len) nx[j] = *(const u32x4*)(up + (size_t)(rr + 1) * NUP); }
#pragma unroll
            for (int j = 0; j < 8; ++j) {
                const int rr = g8 * 8 + j;
                const u32x4 nxt = nx[j];
                const f32x4 ap = (f32x4){bf_lo(prev.x), bf_hi(prev.x), bf_lo(prev.y), bf_hi(prev.y)}, gp = (f32x4){bf_lo(prev.z), bf_hi(prev.z), bf_lo(prev.w), bf_hi(prev.w)};
                const f32x4 ac = (f32x4){bf_lo(cur.x), bf_hi(cur.x), bf_lo(cur.y), bf_hi(cur.y)}, gc = (f32x4){bf_lo(cur.z), bf_hi(cur.z), bf_lo(cur.w), bf_hi(cur.w)};
                const f32x4 an = (f32x4){bf_lo(nxt.x), bf_hi(nxt.x), bf_lo(nxt.y), bf_hi(nxt.y)}, gn = (f32x4){bf_lo(nxt.z), bf_hi(nxt.z), bf_lo(nxt.w), bf_hi(nxt.w)};
                const f32x4 a = ba + wa0 * ap + wa1 * ac + wa2 * an;
                const f32x4 g = bg + wg0 * gp + wg1 * gc + wg2 * gn;
                u32x2 wv; wv.x = cvt_pk_bf16(silu_f(g[0]) * a[0], silu_f(g[1]) * a[1]); wv.y = cvt_pk_bf16(silu_f(g[2]) * a[2], silu_f(g[3]) * a[3]);
                *(u32x2*)(ACT + (size_t)(r0 + rr) * DFF + 4 * q) = wv;
                prev = cur; cur = nxt;
            }
        }
    }
}

__device__ __forceinline__ void convfix_phase(const u32x4* HALO, bf16_t* ACT, const float* cw, const float* cb, int nblk) {
    const int tid = tid_fresh();
    const int total = nblk * 2 * 704;
    const u32x4 zero = (u32x4){0u, 0u, 0u, 0u};
    for (int it = blockIdx.x * NTHREADS + tid; it < total; it += gridDim.x * NTHREADS) {
        const int q = it % 704, rr = it / 704, kb = rr >> 1, last = rr & 1;
        const int R = kb * 64 + (last ? 63 : 0);
        const int pos = R < ML ? (R & 2047) : ((R - ML) & 255), len = R < ML ? 2048 : 256;
        u32x4 pv = zero, cv, nv = zero;
        if (!last) { cv = HALO[(size_t)(kb * 4 + 0) * 704 + q]; nv = HALO[(size_t)(kb * 4 + 1) * 704 + q]; if (pos > 0) pv = HALO[(size_t)(kb * 4 - 1) * 704 + q]; }
        else { pv = HALO[(size_t)(kb * 4 + 2) * 704 + q]; cv = HALO[(size_t)(kb * 4 + 3) * 704 + q]; if (pos < len - 1) nv = HALO[(size_t)(kb * 4 + 4) * 704 + q]; }
        const pg8::ConvW w = pg8::load_convw(cw, cb, q);
        *(pg8::u32x2e*)(ACT + (size_t)R * DFF + 4 * q) = pg8::conv_act(w, pv, cv, nv);
    }
}

__device__ __forceinline__ void combine_phase(const bf16_t* Yf, const bf16_t* Yb, const bf16_t* PX, bf16_t* Y) {
    const int tid = tid_fresh(), lane = tid & 63, gw = blockIdx.x * 8 + (tid >> 6), nw = gridDim.x * 8;
    for (int row0 = gw; row0 < MT; row0 += 4 * nw) {
        u32x4 av[4], bv[4], gv[4]; bool ok[4];
#pragma unroll
        for (int u = 0; u < 4; ++u) {
            const int row = row0 + u * nw; ok[u] = row < MT;
            const int rr = ok[u] ? row : row0;
            av[u] = *(const u32x4*)(Yf + (size_t)rr * 512 + lane * 8); bv[u] = *(const u32x4*)(Yb + (size_t)rr * 512 + lane * 8);
            gv[u] = *(const u32x4*)(PX + (size_t)rr * ABIN + 1536 + lane * 8);
        }
#pragma unroll
        for (int u = 0; u < 4; ++u) {
            if (!ok[u]) continue;
            const int row = row0 + u * nw;
            const u32x4 a = av[u], b = bv[u], g = gv[u];
            float y[8], gg[8];
            y[0] = bf_lo(a.x) + bf_lo(b.x); y[1] = bf_hi(a.x) + bf_hi(b.x); y[2] = bf_lo(a.y) + bf_lo(b.y); y[3] = bf_hi(a.y) + bf_hi(b.y);
            y[4] = bf_lo(a.z) + bf_lo(b.z); y[5] = bf_hi(a.z) + bf_hi(b.z); y[6] = bf_lo(a.w) + bf_lo(b.w); y[7] = bf_hi(a.w) + bf_hi(b.w);
            gg[0] = bf_lo(g.x); gg[1] = bf_hi(g.x); gg[2] = bf_lo(g.y); gg[3] = bf_hi(g.y); gg[4] = bf_lo(g.z); gg[5] = bf_hi(g.z); gg[6] = bf_lo(g.w); gg[7] = bf_hi(g.w);
            float ss = 0.f;
#pragma unroll
            for (int i = 0; i < 8; ++i) ss += y[i] * y[i];
            ss += __shfl_xor(ss, 1); ss += __shfl_xor(ss, 2); ss += __shfl_xor(ss, 4); ss += __shfl_xor(ss, 8);
            const float rinv = rsqrtf(ss * (1.0f / 128.0f) + EPSN);
            float o[8];
#pragma unroll
            for (int i = 0; i < 8; ++i) o[i] = y[i] * rinv * silu_f(gg[i]);
            u32x4 wv; wv.x = cvt_pk_bf16(o[0], o[1]); wv.y = cvt_pk_bf16(o[2], o[3]); wv.z = cvt_pk_bf16(o[4], o[5]); wv.w = cvt_pk_bf16(o[6], o[7]);
            *(u32x4*)(Y + (size_t)row * 1024 + lane * 8) = wv;
        }
    }
}

__device__ __forceinline__ u32x4 scale8(u32x4 v, float s) {
    u32x4 r;
    r.x = cvt_pk_bf16v(bf_lo(v.x) * s, bf_hi(v.x) * s); r.y = cvt_pk_bf16v(bf_lo(v.y) * s, bf_hi(v.y) * s);
    r.z = cvt_pk_bf16v(bf_lo(v.z) * s, bf_hi(v.z) * s); r.w = cvt_pk_bf16v(bf_lo(v.w) * s, bf_hi(v.w) * s);
    return r;
}
__device__ __forceinline__ void retention_phase(const Params& p, LAS unsigned char* lds, const bf16_t* PX, bf16_t* Yf, bf16_t* Yb) {
    const int tid = tid_fresh(), lane = tid & 63, w = __builtin_amdgcn_readfirstlane(tid >> 6), l15 = lane & 15, quad = lane >> 4, qq = l15 >> 2, pp = lane & 3;
    LAS unsigned char* Qs = lds; LAS unsigned char* Ks = lds + 32768; LAS unsigned char* Vs = lds + 65536; LAS unsigned char* As = lds + 98304;
    const unsigned fl = (((unsigned)l15 & 3u) << 2) | (((unsigned)l15 >> 2) & 3u);
    unsigned ra[4], q2a[4], q2b[4], awb, tv1, tv2, tk1b, tk2b;
#pragma unroll
    for (int ks = 0; ks < 4; ++ks) {
        ra[ks] = 256u * l15 + 16u * (((unsigned)(4 * ks + quad)) ^ fl);
        q2a[ks] = 256u * l15 + 16u * (((unsigned)(4 * ks + (quad >> 1))) ^ fl) + 8u * (quad & 1);
        q2b[ks] = 256u * l15 + 16u * (((unsigned)(4 * ks + 2 + (quad >> 1))) ^ fl) + 8u * (quad & 1);
    }
    awb = 256u * (16 * w + l15) + 16u * (((unsigned)(quad >> 1)) ^ fl) + 8u * (quad & 1);
    {
        const unsigned r1 = (unsigned)(8 * quad + qq), r2 = r1 + 4u;
        const unsigned f1 = ((r1 & 3u) << 2) | ((r1 >> 2) & 3u), f2 = ((r2 & 3u) << 2) | ((r2 >> 2) & 3u);
        tv1 = 256u * r1 + 16u * (((unsigned)(2 * w + (pp >> 1))) ^ f1) + 8u * (pp & 1);
        tv2 = 256u * r2 + 16u * (((unsigned)(2 * w + (pp >> 1))) ^ f2) + 8u * (pp & 1);
        tk1b = 256u * r1 + 16u * (((unsigned)(pp >> 1)) ^ f1) + 8u * (pp & 1); tk2b = 256u * r2 + 16u * (((unsigned)(pp >> 1)) ^ f2) + 8u * (pp & 1);
    }
    for (int item = blockIdx.x; item < 256; item += gridDim.x) {
        const int dir = item & 1, h = (item >> 1) & 3, b = item >> 3;
        const float de = p.ret_decay[dir * 4 + h];
        const float lg2 = log1pf(-exp2f(-de)) * 1.4426950408889634f;
        const float cdec = exp2f(lg2 * 128.0f);
        f32x4 S[8];
#pragma unroll
        for (int i = 0; i < 8; ++i) S[i] = (f32x4){0.f, 0.f, 0.f, 0.f};
        bf16_t* Yo = dir ? Yb : Yf;
#define RET_C0(S) ((S) < 2 ? ML + b * 256 + (dir ? 1 - (S) : (S)) * 128 : b * 2048 + (dir ? 17 - (S) : (S) - 2) * 128)
#define RET_LOAD(S) do { const int c0n_ = RET_C0(S); _Pragma("unroll") for (int c = 0; c < 4; ++c) { const int idx = tid + 512 * c, i = idx >> 4, ch = idx & 15; \
            const int tok = dir ? c0n_ + 127 - i : c0n_ + i; const bf16_t* src = PX + (size_t)tok * ABIN + h * 128 + ch * 8; \
            qn[c] = *(const u32x4*)(src); kn[c] = *(const u32x4*)(src + 512); vn[c] = *(const u32x4*)(src + 1024); } } while (0)
        u32x4 qn[4], kn[4], vn[4];
        RET_LOAD(0);
        for (int s = 0; s < 18; ++s) {
            const int c0 = RET_C0(s);
            __syncthreads();
#pragma unroll
            for (int c = 0; c < 4; ++c) {
                const int idx = tid + 512 * c, i = idx >> 4, ch = idx & 15;
                const unsigned o = off256(i, ch);
                *(LAS u32x4*)(Qs + o) = qn[c]; *(LAS u32x4*)(Vs + o) = vn[c];
                *(LAS u32x4*)(Ks + o) = scale8(kn[c], __builtin_amdgcn_exp2f(lg2 * (float)(127 - i)));
            }
            __syncthreads();
            if (s + 1 < 18) { RET_LOAD(s + 1); }
            {
                bf16x8 qf[4];
#pragma unroll
                for (int ks = 0; ks < 4; ++ks) qf[ks] = *(LAS bf16x8*)(Qs + ra[ks] + 4096u * w);
                const int i = 16 * w + l15;
                const float rowsc = __builtin_amdgcn_exp2f(lg2 * (float)(i - 127));
#pragma unroll
                for (int nt = 0; nt < 8; ++nt) {
                    f32x4 at = (f32x4){0.f, 0.f, 0.f, 0.f};
                    if (nt <= w) {
#pragma unroll
                        for (int ks = 0; ks < 4; ++ks) { const bf16x8 kf = *(LAS bf16x8*)(Ks + ra[ks] + 4096u * nt); at = MFMA16(kf, qf[ks], at); }
#pragma unroll
                        for (int jj = 0; jj < 4; ++jj) { const int diff = i - (16 * nt + 4 * quad + jj); const bool keep = dir ? (diff > 0) : (diff >= 0); at[jj] = keep ? at[jj] * rowsc : 0.f; }
                    }
                    u32x2 wv; wv.x = cvt_pk_bf16v(at[0], at[1]); wv.y = cvt_pk_bf16v(at[2], at[3]);
                    *(LAS u32x2*)(As + (awb ^ (32u * nt))) = wv;
                }
            }
            __syncthreads();
            bf16x8 vf[4], sf[4];
#pragma unroll
            for (int ks = 0; ks < 4; ++ks) {
                vf[ks] = cat4(tr_read(Vs + tv1 + 8192u * ks), tr_read(Vs + tv2 + 8192u * ks));
                sf[ks] = pack8v(S[2 * ks], S[2 * ks + 1]);
            }
#pragma unroll
            for (int it = 0; it < 8; ++it) {
                f32x4 o2 = (f32x4){0.f, 0.f, 0.f, 0.f};
#pragma unroll
                for (int pk = 0; pk < 4; ++pk) {
                    const s16x4 qa = *(LAS s16x4*)(Qs + q2a[pk] + 4096u * it);
                    const s16x4 qb = *(LAS s16x4*)(Qs + q2b[pk] + 4096u * it);
                    o2 = MFMA16(sf[pk], cat4(qa, qb), o2);
                }
                f32x4 o1 = (f32x4){0.f, 0.f, 0.f, 0.f};
#pragma unroll
                for (int ks = 0; ks < 4; ++ks) if (ks <= (it >> 1)) { const bf16x8 af = *(LAS bf16x8*)(As + ra[ks] + 4096u * it); o1 = MFMA16(vf[ks], af, o1); }
                const int i = 16 * it + l15;
                const float qd = __builtin_amdgcn_exp2f(lg2 * (float)(i + 1));
                const int tok = dir ? c0 + 127 - i : c0 + i;
                u32x2 wv; wv.x = cvt_pk_bf16v(o1[0] + qd * o2[0], o1[1] + qd * o2[1]); wv.y = cvt_pk_bf16v(o1[2] + qd * o2[2], o1[3] + qd * o2[3]);
                *(u32x2*)(Yo + (size_t)tok * 512 + h * 128 + 16 * w + 4 * quad) = wv;
            }
#pragma unroll
            for (int dt = 0; dt < 8; ++dt) {
                f32x4 acc = S[dt] * cdec;
#pragma unroll
                for (int ks = 0; ks < 4; ++ks) {
                    const bf16x8 kf = cat4(tr_read(Ks + (tk1b ^ (32u * dt)) + 8192u * ks), tr_read(Ks + (tk2b ^ (32u * dt)) + 8192u * ks));
                    acc = MFMA16(kf, vf[ks], acc);
                }
                S[dt] = acc;
            }
        }
    }
    __syncthreads();
#undef RET_C0
#undef RET_LOAD
}

__device__ __forceinline__ void swa_phase(const Params& p, LAS unsigned char* lds, const bf16_t* PX, bf16_t* Y) {
    const int tid = tid_fresh(), lane = tid & 63, w = __builtin_amdgcn_readfirstlane(tid >> 6), l15 = lane & 15, quad = lane >> 4, qq = l15 >> 2, pp = lane & 3;
    LAS unsigned char* Ks = lds; LAS unsigned char* Vs = lds + 16384;
    unsigned ka[2], va[4];
#pragma unroll
    for (int ks = 0; ks < 2; ++ks) ka[ks] = 128u * l15 + 16u * (((unsigned)(4 * ks + quad)) ^ ((unsigned)l15 & 7u));
#pragma unroll
    for (int vt = 0; vt < 4; ++vt) va[vt] = 128u * (4 * quad + qq) + 16u * (((unsigned)(2 * vt + (pp >> 1))) ^ ((unsigned)(4 * quad + qq) & 7u)) + 8u * (pp & 1);
#define SWA_MASK(IT) ((IT) >= 1024 ? 0x18u : (0x1Au | (((IT) & 15) > 0 ? 1u : 0u) | (((IT) & 15) < 15 ? 4u : 0u)))
#define SWA_PREF(IT, C) do { int b_, kvh_, qb_; if ((IT) < 1024) { qb_ = (IT) & 15; kvh_ = ((IT) >> 4) & 1; b_ = (IT) >> 5; } else { const int t_ = (IT) - 1024; qb_ = t_ & 1; kvh_ = (t_ >> 1) & 1; b_ = t_ >> 2; } \
        const size_t kr_ = (C) < 3 ? (size_t)b_ * 2048 + (qb_ - 1 + (C)) * 128 : (size_t)ML + b_ * 256 + ((C) - 3) * 128; \
        _Pragma("unroll") for (int cc = 0; cc < 2; ++cc) { const int idx = tid + 512 * cc, j = idx >> 3, ch = idx & 7; const bf16_t* src = PX + (kr_ + j) * ABIN + 2560 + kvh_ * 64 + ch * 8; \
            kreg[cc] = *(const u32x4*)(src); vreg[cc] = *(const u32x4*)(src + 128); } } while (0)
    int item = blockIdx.x;
    if (item < 1152) {
    u32x4 kreg[2], vreg[2];
    unsigned msk = SWA_MASK(item);
    int c = __builtin_ctz(msk);
    SWA_PREF(item, c);
    for (;;) {
        const bool isctx = item >= 1024;
        int b, kvh, qb;
        if (!isctx) { qb = item & 15; kvh = (item >> 4) & 1; b = item >> 5; } else { const int t = item - 1024; qb = t & 1; kvh = (t >> 1) & 1; b = t >> 2; }
        const int qh = kvh * 4 + (w >> 1);
        const int qpos0 = qb * 128 + 64 * (w & 1);
        const size_t qrow0 = isctx ? (size_t)ML + b * 256 + qpos0 : (size_t)b * 2048 + qpos0;
        bf16x8 qf[4][2];
#pragma unroll
        for (int it = 0; it < 4; ++it)
#pragma unroll
            for (int ks = 0; ks < 2; ++ks) qf[it][ks] = *(const bf16x8*)(PX + (qrow0 + 16 * it + l15) * ABIN + 2048 + qh * 64 + 32 * ks + 8 * quad);
        const float sink = p.swa_sink[qh] * 1.4426950408889634f;
        float mrun[4], lrun[4]; f32x4 o[4][4];
#pragma unroll
        for (int it = 0; it < 4; ++it) { mrun[it] = sink; lrun[it] = 0.f;
#pragma unroll
            for (int vt = 0; vt < 4; ++vt) o[vt][it] = (f32x4){0.f, 0.f, 0.f, 0.f}; }
        const int nxt_item = item + (int)gridDim.x;
        for (;;) {
            const bool local = c < 3;
            const int kstart = (qb - 1 + c) * 128;
            __syncthreads();
#pragma unroll
            for (int cc = 0; cc < 2; ++cc) { const int idx = tid + 512 * cc, j = idx >> 3, ch = idx & 7; *(LAS u32x4*)(Ks + off128(j, ch)) = kreg[cc]; *(LAS u32x4*)(Vs + off128(j, ch)) = vreg[cc]; }
            __syncthreads();
            const unsigned rest = msk & ~((2u << c) - 1u);
            int nc = 0;
            if (rest) { nc = __builtin_ctz(rest); SWA_PREF(item, nc); }
            else if (nxt_item < 1152) { nc = __builtin_ctz(SWA_MASK(nxt_item)); SWA_PREF(nxt_item, nc); }
            for (int kk = 0; kk < 4; ++kk) {
                const int g0 = kstart + 32 * kk;
                if (local && (g0 + 31 < qpos0 - 128 || g0 > qpos0 + 63 + 128)) continue;
                const bool needmask = local && !(g0 >= qpos0 - 65 && g0 + 31 <= qpos0 + 128);
                f32x4 st[4][2];
#pragma unroll
                for (int it = 0; it < 4; ++it) { st[it][0] = (f32x4){0.f, 0.f, 0.f, 0.f}; st[it][1] = (f32x4){0.f, 0.f, 0.f, 0.f}; }
#pragma unroll
                for (int jt = 0; jt < 2; ++jt)
#pragma unroll
                    for (int ks = 0; ks < 2; ++ks) {
                        const bf16x8 kf = *(LAS bf16x8*)(Ks + ka[ks] + 128u * (32 * kk + 16 * jt));
#pragma unroll
                        for (int it = 0; it < 4; ++it) st[it][jt] = MFMA16(kf, qf[it][ks], st[it][jt]);
                    }
                bf16x8 pf[4];
#pragma unroll
                for (int it = 0; it < 4; ++it) {
                    float mx = -1e30f;
                    if (needmask) {
                        const int qpos = qpos0 + 16 * it + l15;
#pragma unroll
                        for (int jt = 0; jt < 2; ++jt)
#pragma unroll
                            for (int jj = 0; jj < 4; ++jj) { const int d = qpos - (g0 + 16 * jt + 4 * quad + jj); if (d > 128 || d < -128) st[it][jt][jj] = -1e30f; }
                    }
#pragma unroll
                    for (int jt = 0; jt < 2; ++jt)
#pragma unroll
                        for (int jj = 0; jj < 4; ++jj) mx = fmaxf(mx, st[it][jt][jj]);
                    mx = fmaxf(mx, __shfl_xor(mx, 16)); mx = fmaxf(mx, __shfl_xor(mx, 32));
                    const float mnew = fmaxf(mrun[it], mx);
                    const float sc = __builtin_amdgcn_exp2f(mrun[it] - mnew);
                    float ps = 0.f;
#pragma unroll
                    for (int jt = 0; jt < 2; ++jt)
#pragma unroll
                        for (int jj = 0; jj < 4; ++jj) { const float e = __builtin_amdgcn_exp2f(st[it][jt][jj] - mnew); st[it][jt][jj] = e; ps += e; }
                    lrun[it] = lrun[it] * sc + ps; mrun[it] = mnew;
                    if (__builtin_amdgcn_ballot_w64(sc < 1.0f) != 0ull) {
#pragma unroll
                        for (int vt = 0; vt < 4; ++vt) o[vt][it] *= sc;
                    }
                    pf[it] = pack8(st[it][0], st[it][1]);
                }
#pragma unroll
                for (int vt = 0; vt < 4; ++vt) {
                    const bf16x8 vf = cat4(tr_read(Vs + va[vt] + 128u * (32 * kk)), tr_read(Vs + va[vt] + 128u * (32 * kk + 16)));
#pragma unroll
                    for (int it = 0; it < 4; ++it) o[vt][it] = MFMA16(vf, pf[it], o[vt][it]);
                }
            }
            if (!rest) { c = nc; break; }
            c = nc;
        }
#pragma unroll
        for (int it = 0; it < 4; ++it) {
            float lt = lrun[it]; lt += __shfl_xor(lt, 16); lt += __shfl_xor(lt, 32);
            lt += __builtin_amdgcn_exp2f(sink - mrun[it]);
            const float inv = 1.0f / lt;
            bf16_t* dst = Y + (qrow0 + 16 * it + l15) * 1024 + 512 + qh * 64 + 4 * quad;
#pragma unroll
            for (int vt = 0; vt < 4; ++vt) { u32x2 wv; wv.x = cvt_pk_bf16(o[vt][it][0] * inv, o[vt][it][1] * inv); wv.y = cvt_pk_bf16(o[vt][it][2] * inv, o[vt][it][3] * inv); *(u32x2*)(dst + 16 * vt) = wv; }
        }
        item = nxt_item;
        if (item >= 1152) break;
        msk = SWA_MASK(item);
    }
    }
#undef SWA_MASK
#undef SWA_PREF
    __syncthreads();
}

__device__ __forceinline__ void na_phase(const Params& p, LAS unsigned char* lds, const bf16_t* QKV, bf16_t* Y) {
    const int tid = tid_fresh(), lane = tid & 63, w = __builtin_amdgcn_readfirstlane(tid >> 6), l15 = lane & 15, quad = lane >> 4, qq = l15 >> 2, pp = lane & 3;
    LAS unsigned char* Ks = lds; LAS unsigned char* Vs = lds + 32768; LAS float* rp = (LAS float*)(lds + 65536);
    const int hh = w >> 2, m = w & 3;
    const int pq = ((quad & 1) << 1) | (quad >> 1);
    const int kl = (((((l15 >> 2) & 1) << 1) | (l15 >> 3)) << 2) | (l15 & 3);
    const int sup0 = min(max(16 * m - 8, 0), 32);
    const int qc = 16 * m + l15, qstart = min(max(qc - 8, 0), 48);
    unsigned kaL[2], kaC[2], vaL[4], vaC[4];
    {
        const unsigned rl = (unsigned)(sup0 + kl), fL = ((rl & 3u) << 2) | ((rl >> 2) & 3u), rc = (unsigned)kl, fC = ((rc & 3u) << 2) | ((rc >> 2) & 3u);
#pragma unroll
        for (int ks = 0; ks < 2; ++ks) { kaL[ks] = 256u * rl + 16u * (((unsigned)(8 * hh + 4 * ks + quad)) ^ fL); kaC[ks] = 256u * rc + 16u * (((unsigned)(8 * hh + 4 * ks + quad)) ^ fC); }
        const unsigned r1l = (unsigned)(sup0 + 4 * pq + qq), f1L = ((r1l & 3u) << 2) | ((r1l >> 2) & 3u), r1c = (unsigned)(4 * pq + qq), f1C = ((r1c & 3u) << 2) | ((r1c >> 2) & 3u);
#pragma unroll
        for (int vt = 0; vt < 4; ++vt) { vaL[vt] = 256u * r1l + 16u * (((unsigned)(8 * hh + 2 * vt + (pp >> 1))) ^ f1L) + 8u * (pp & 1); vaC[vt] = 256u * r1c + 16u * (((unsigned)(8 * hh + 2 * vt + (pp >> 1))) ^ f1C) + 8u * (pp & 1); }
    }
    int bofs[2][4];
#pragma unroll
    for (int jt = 0; jt < 2; ++jt)
#pragma unroll
        for (int jj = 0; jj < 4; ++jj) {
            const int kc = sup0 + 16 * jt + 4 * pq + jj;
            const bool valid = (kc >= qstart) && (kc < qstart + 16);
            bofs[jt][jj] = 4 * (hh * 480 + (valid ? (kc - qc + 15) : 31));
        }
    bool hi[4]; int bsel[4];
#pragma unroll
    for (int jj = 0; jj < 4; ++jj) {
        const int kc0 = sup0 + 4 * pq + jj;
        hi[jj] = !((kc0 >= qstart) && (kc0 < qstart + 16));
        bsel[jj] = 4 * (hh * 480 + ((hi[jj] ? kc0 + 16 : kc0) - qc + 15));
    }
    const int nitems = 8192;
    int item = blockIdx.x;
    if (item < nitems) {
        u32x4 kreg[4], vreg[4]; bf16x8 qnext[2];
        int cur_hp = -1;
#define NA_PREF(IT, C) do { const int hp_ = (IT) & 7, r_ = ((IT) >> 3) & 31, b_ = (IT) >> 8; const int rs_ = min(max(r_ - 4, 0), 24); \
        _Pragma("unroll") for (int cc = 0; cc < 4; ++cc) { const int idx = tid + 512 * cc, j = idx >> 4, ch = idx & 15; \
            const size_t tok = (C) < 4 ? (size_t)b_ * 2048 + (rs_ + 2 * (C) + (j >> 6)) * 64 + (j & 63) : (size_t)ML + b_ * 256 + ((C) - 4) * 128 + j; \
            const bf16_t* src = QKV + tok * NA3 + 1024 + hp_ * 128 + ch * 8; kreg[cc] = *(const u32x4*)(src); vreg[cc] = *(const u32x4*)(src + 1024); } } while (0)
#define NA_PREFQ(IT) do { const int hp_ = (IT) & 7, r_ = ((IT) >> 3) & 31, b_ = (IT) >> 8; const size_t qt_ = (size_t)b_ * 2048 + r_ * 64 + 16 * m + l15; \
        _Pragma("unroll") for (int ks = 0; ks < 2; ++ks) qnext[ks] = *(const bf16x8*)(QKV + qt_ * NA3 + (2 * hp_ + hh) * 64 + 32 * ks + 8 * quad); } while (0)
#define NA_STAGE(C) do { __syncthreads(); \
        if ((C) == 0 && hp != cur_hp) { for (int idx = tid; idx < 960; idx += NTHREADS) { const int hq = idx / 480, rem = idx - hq * 480, dr = rem >> 5, dc = rem & 31; rp[idx] = dc < 31 ? p.na_rpb[(2 * hp + hq) * 465 + dr * 31 + dc] * 1.4426950408889634f : -1e30f; } cur_hp = hp; } \
        _Pragma("unroll") for (int cc = 0; cc < 4; ++cc) { const int idx = tid + 512 * cc, j = idx >> 4, ch = idx & 15; *(LAS u32x4*)(Ks + off256(j, ch)) = kreg[cc]; *(LAS u32x4*)(Vs + off256(j, ch)) = vreg[cc]; } \
        __syncthreads(); } while (0)
#define NA_SOFTMAX_PV(VA, VOFF0, VOFF1) do { \
        float mx = -1e30f; \
        _Pragma("unroll") for (int gi = 0; gi < 2; ++gi) _Pragma("unroll") for (int jt = 0; jt < 2; ++jt) _Pragma("unroll") for (int jj = 0; jj < 4; ++jj) mx = fmaxf(mx, s[gi][jt][jj]); \
        mx = fmaxf(mx, __shfl_xor(mx, 16)); mx = fmaxf(mx, __shfl_xor(mx, 32)); \
        const float mnew = fmaxf(mrun, mx); const float sc = __builtin_amdgcn_exp2f(mrun - mnew); float ps = 0.f; \
        _Pragma("unroll") for (int gi = 0; gi < 2; ++gi) _Pragma("unroll") for (int jt = 0; jt < 2; ++jt) _Pragma("unroll") for (int jj = 0; jj < 4; ++jj) { const float e = __builtin_amdgcn_exp2f(s[gi][jt][jj] - mnew); s[gi][jt][jj] = e; ps += e; } \
        lrun = lrun * sc + ps; mrun = mnew; \
        _Pragma("unroll") for (int vt = 0; vt < 4; ++vt) o[vt] *= sc; \
        _Pragma("unroll") for (int gi = 0; gi < 2; ++gi) { const bf16x8 pf = pack8(s[gi][0], s[gi][1]); const unsigned vo = gi ? (VOFF1) : (VOFF0); \
            _Pragma("unroll") for (int vt = 0; vt < 4; ++vt) { const bf16x8 vf = cat4(tr_read(Vs + VA[vt] + vo), tr_read(Vs + VA[vt] + vo + 4096u)); o[vt] = MFMA16(vf, pf, o[vt]); } } } while (0)
        NA_PREF(item, 0); NA_PREFQ(item);
        for (;;) {
            const int hp = item & 7, r = (item >> 3) & 31, b = item >> 8;
            const int h = 2 * hp + hh;
            const int rs = min(max(r - 4, 0), 24);
            const size_t qtok = (size_t)b * 2048 + r * 64 + 16 * m + l15;
            bf16x8 qf[2]; qf[0] = qnext[0]; qf[1] = qnext[1];
            float mrun = -1e30f, lrun = 0.f; f32x4 o[4];
#pragma unroll
            for (int vt = 0; vt < 4; ++vt) o[vt] = (f32x4){0.f, 0.f, 0.f, 0.f};
            const int nxt_item = item + (int)gridDim.x;
            for (int c = 0; c < 4; ++c) {
                NA_STAGE(c);
                NA_PREF(item, c + 1);
                f32x4 s[2][2];
#pragma unroll
                for (int gi = 0; gi < 2; ++gi)
#pragma unroll
                    for (int jt = 0; jt < 2; ++jt) {
                        s[gi][jt] = (f32x4){0.f, 0.f, 0.f, 0.f};
#pragma unroll
                        for (int ks = 0; ks < 2; ++ks) { const bf16x8 kf = *(LAS bf16x8*)(Ks + kaL[ks] + 256u * (64 * gi + 16 * jt)); s[gi][jt] = MFMA16(kf, qf[ks], s[gi][jt]); }
                    }
                {
                    f32x4 t[2];
#pragma unroll
                    for (int gi = 0; gi < 2; ++gi) {
                        const int rowoff = 4 * ((rs + 2 * c + gi - r + 7) * 32);
#pragma unroll
                        for (int jj = 0; jj < 4; ++jj) t[gi][jj] = (hi[jj] ? s[gi][1][jj] : s[gi][0][jj]) + *(LAS float*)((LAS unsigned char*)rp + (bsel[jj] + rowoff));
                    }
                    float mx = fmaxf(fmaxf(fmaxf(t[0][0], t[0][1]), fmaxf(t[0][2], t[0][3])), fmaxf(fmaxf(t[1][0], t[1][1]), fmaxf(t[1][2], t[1][3])));
                    mx = fmaxf(mx, __shfl_xor(mx, 16)); mx = fmaxf(mx, __shfl_xor(mx, 32));
                    const float mnew = fmaxf(mrun, mx); const float sc = __builtin_amdgcn_exp2f(mrun - mnew); float ps = 0.f;
#pragma unroll
                    for (int gi = 0; gi < 2; ++gi)
#pragma unroll
                        for (int jj = 0; jj < 4; ++jj) { const float e = __builtin_amdgcn_exp2f(t[gi][jj] - mnew); ps += e; s[gi][0][jj] = hi[jj] ? 0.f : e; s[gi][1][jj] = hi[jj] ? e : 0.f; }
                    lrun = lrun * sc + ps; mrun = mnew;
#pragma unroll
                    for (int vt = 0; vt < 4; ++vt) o[vt] *= sc;
#pragma unroll
                    for (int gi = 0; gi < 2; ++gi) {
                        const bf16x8 pf = pack8(s[gi][0], s[gi][1]); const unsigned vo = gi ? 16384u : 0u;
#pragma unroll
                        for (int vt = 0; vt < 4; ++vt) { const bf16x8 vf = cat4(tr_read(Vs + vaL[vt] + vo), tr_read(Vs + vaL[vt] + vo + 4096u)); o[vt] = MFMA16(vf, pf, o[vt]); }
                    }
                }
            }
            for (int c = 4; c < 6; ++c) {
                NA_STAGE(c);
                if (c < 5) { NA_PREF(item, c + 1); }
                else if (nxt_item < nitems) { NA_PREF(nxt_item, 0); NA_PREFQ(nxt_item); }
#pragma unroll
                for (int st = 0; st < 2; ++st) {
                    f32x4 s[2][2];
#pragma unroll
                    for (int gi = 0; gi < 2; ++gi)
#pragma unroll
                        for (int jt = 0; jt < 2; ++jt) {
                            s[gi][jt] = (f32x4){0.f, 0.f, 0.f, 0.f};
#pragma unroll
                            for (int ks = 0; ks < 2; ++ks) { const bf16x8 kf = *(LAS bf16x8*)(Ks + kaC[ks] + 256u * (64 * st + 32 * gi + 16 * jt)); s[gi][jt] = MFMA16(kf, qf[ks], s[gi][jt]); }
                        }
                    NA_SOFTMAX_PV(vaC, 256u * (64 * st), 256u * (64 * st + 32));
                }
            }
            float lt = lrun; lt += __shfl_xor(lt, 16); lt += __shfl_xor(lt, 32);
            const float inv = 1.0f / lt;
            bf16_t* dst = Y + qtok * 1024 + h * 64 + 4 * quad;
#pragma unroll
            for (int vt = 0; vt < 4; ++vt) { u32x2 wv; wv.x = cvt_pk_bf16(o[vt][0] * inv, o[vt][1] * inv); wv.y = cvt_pk_bf16(o[vt][2] * inv, o[vt][3] * inv); *(u32x2*)(dst + 16 * vt) = wv; }
            item = nxt_item;
            if (item >= nitems) break;
        }
#undef NA_PREF
#undef NA_PREFQ
#undef NA_STAGE
#undef NA_SOFTMAX_PV
    }
    __syncthreads();
}


__device__ __forceinline__ void run_gemm(LAS unsigned char* lds, const bf16_t* A, const bf16_t* Bt, int M, int N, int K, bf16_t* O, int ldc, int mode, const unsigned char* ws) {
    pg8::Gemm g{A, Bt, M, N, K};
    pg8::StaticOrder S; S.init(M, N, (int)gridDim.x, (int)blockIdx.x);
    pg8::EpiOut E{O, ldc, mode, (const f32x4*)(ws + WS_RRET), (const f32x4*)(ws + WS_R2D)};
    pg8::gemm_phase<pg8::EpiOut, pg8::StaticOrder, false>(lds, g, S, E, nullptr);
}
__device__ __forceinline__ void run_gemm_conv(LAS unsigned char* lds, const bf16_t* A, const bf16_t* Bt, int M, bf16_t* ACT, u32x4* HALO, const float* cw, const float* cb) {
    pg8::Gemm g{A, Bt, M, NUP, 1024};
    pg8::StaticOrder S; S.init(M, NUP, (int)gridDim.x, (int)blockIdx.x);
    pg8::EpiConv E{ACT, (pg8::u32x4*)HALO, cw, cb};
    pg8::gemm_phase<pg8::EpiConv, pg8::StaticOrder, false>(lds, g, S, E, nullptr);
}

__global__ void __launch_bounds__(NTHREADS, 2) hybrid_fwd_megakernel(Params p) {
    extern __shared__ __attribute__((aligned(16))) unsigned char lds_raw[];
    LAS unsigned char* lds = (LAS unsigned char*)lds_raw;
    cg::grid_group grid = cg::this_grid();
    unsigned char* ws = p.ws;
    bf16_t* H = (bf16_t*)(ws + WS_H); bf16_t* PX = (bf16_t*)(ws + WS_PX); bf16_t* Y = (bf16_t*)(ws + WS_Y); bf16_t* OX = (bf16_t*)(ws + WS_OX);
    bf16_t* ACT = PX; u32x4* HALO = (u32x4*)(ws + WS_HALO); bf16_t* Yf = OX; bf16_t* Yb = OX + (size_t)MT * 512;
    float* CTXR = (float*)(ws + WS_CTX);
    const float* mod0 = (const float*)(ws + WS_MOD); const float* mod1 = mod0 + 33 * 6144;
    const bf16_t* WABI = (const bf16_t*)(ws + WS_WABI); const bf16_t* WABO = (const bf16_t*)(ws + WS_WABO);
    const bf16_t* WNAI = (const bf16_t*)(ws + WS_WNAI); const bf16_t* WNAO = (const bf16_t*)(ws + WS_WNAO);
    const bf16_t* WUP = (const bf16_t*)(ws + WS_WUP); const bf16_t* WDN = (const bf16_t*)(ws + WS_WDN);
    const float* ng0 = p.norm_g; const float* ng1 = p.norm_g + 4096;

    volatile LAS unsigned* xst = (volatile LAS unsigned*)(lds + LDS_BYTES - 16);
    if (threadIdx.x < 4) xst[threadIdx.x] = 0u;
    __syncthreads();
    const XcdBarrier xbar = xcd_barrier_post((unsigned*)(ws + WS_BAR), xst);
#define GSYNC() xcd_barrier(xbar)
#ifdef PROBE_GROUP
    unsigned long long pr_acc = 0, pr_t0 = __builtin_amdgcn_s_memrealtime();
#define PH_END(g) do { const unsigned long long t_ = __builtin_amdgcn_s_memrealtime(); if ((g) == PROBE_GROUP) pr_acc += t_ - pr_t0; pr_t0 = t_; } while (0)
#else
#define PH_END(g) do { } while (0)
#endif
    prep_phase(p, lds);
    grid.sync(); PH_END(7);
    rowwise_phase(p.x, p.ctx, nullptr, nullptr, nullptr, nullptr, nullptr, ng0, mod0, mod0 + 1024, H, MT);
    GSYNC(); PH_END(2);
    run_gemm(lds, H, WABI, MT, ABIN, 1024, PX, ABIN, 1, ws);
    GSYNC(); PH_END(1);
    retention_phase(p, lds, PX, Yf, Yb); PH_END(8);
    swa_phase(p, lds, PX, Y);
    GSYNC(); PH_END(4);
    combine_phase(Yf, Yb, PX, Y);
    GSYNC(); PH_END(5);
    run_gemm(lds, Y, WABO, MT, 1024, 1024, OX, 1024, 0, ws);
    GSYNC(); PH_END(1);
    rowwise_phase(p.x, p.ctx, p.out, CTXR, OX, ng0 + 1024, mod0 + 2 * 1024, ng0 + 2048, mod0 + 3 * 1024, mod0 + 4 * 1024, H, MT);
    GSYNC(); PH_END(2);
    run_gemm_conv(lds, H, WUP, MT, ACT, HALO, p.ffn_conv_w, p.ffn_conv_b);
    GSYNC(); PH_END(1);
    convfix_phase(HALO, ACT, p.ffn_conv_w, p.ffn_conv_b, MT / 64);
    GSYNC(); PH_END(3);
    run_gemm(lds, ACT, WDN, MT, 1024, DFF, OX, 1024, 0, ws);
    GSYNC(); PH_END(1);
    rowwise_phase(p.out, CTXR, p.out, CTXR, OX, ng0 + 3072, mod0 + 5 * 1024, ng1, mod1, mod1 + 1024, H, MT);
    GSYNC(); PH_END(2);
    run_gemm(lds, H, WNAI, ML, NA3, 1024, PX, NA3, 2, ws);
    run_gemm(lds, H + (size_t)ML * 1024, WNAI + (size_t)1024 * 1024, MC, 2048, 1024, PX + (size_t)ML * NA3 + 1024, NA3, 0, ws);
    GSYNC(); PH_END(1);
    na_phase(p, lds, PX, Y);
    GSYNC(); PH_END(6);
    run_gemm(lds, Y, WNAO, ML, 1024, 1024, OX, 1024, 0, ws);
    GSYNC(); PH_END(1);
    rowwise_phase(p.out, CTXR, p.out, CTXR, OX, ng1 + 1024, mod1 + 2 * 1024, ng1 + 2048, mod1 + 3 * 1024, mod1 + 4 * 1024, H, ML);
    GSYNC(); PH_END(2);
    run_gemm_conv(lds, H, WUP + (size_t)NUP * 1024, ML, ACT, HALO, p.ffn_conv_w + 3 * NUP, p.ffn_conv_b + NUP);
    GSYNC(); PH_END(1);
    convfix_phase(HALO, ACT, p.ffn_conv_w + 3 * NUP, p.ffn_conv_b + NUP, ML / 64);
    GSYNC(); PH_END(3);
    run_gemm(lds, ACT, WDN + (size_t)1024 * DFF, ML, 1024, DFF, OX, 1024, 0, ws);
    GSYNC(); PH_END(1);
    rowwise_phase(p.out, CTXR, p.out, CTXR, OX, ng1 + 3072, mod1 + 5 * 1024, nullptr, nullptr, nullptr, nullptr, ML);
    PH_END(2);
#ifdef PROBE_GROUP
    if (blockIdx.x == 0 && threadIdx.x == 0) { const unsigned long long te = __builtin_amdgcn_s_memrealtime(); while (__builtin_amdgcn_s_memrealtime() - te < 4ull * pr_acc) __builtin_amdgcn_s_sleep(20); }
#endif
}

extern "C" void kernel_launch(void* const* d_in, const int* in_sizes, int n_in, void* d_out, int out_size, void* d_ws, size_t ws_size, hipStream_t stream) {
    static int grid_blocks = 0;
    if (grid_blocks == 0) {
        if (n_in != 18 || ws_size < WS_END) { fprintf(stderr, "kernel_launch: unexpected n_in %d or ws_size %zu (need %zu)\n", n_in, ws_size, (size_t)WS_END); grid_blocks = -1; return; }
        int dev = 0, cus = 0, per_cu = 0;
        hipGetDevice(&dev);
        hipDeviceGetAttribute(&cus, hipDeviceAttributeMultiprocessorCount, dev);
        hipFuncSetAttribute((const void*)hybrid_fwd_megakernel, hipFuncAttributeMaxDynamicSharedMemorySize, LDS_BYTES);
        if (hipOccupancyMaxActiveBlocksPerMultiprocessor(&per_cu, (const void*)hybrid_fwd_megakernel, NTHREADS, LDS_BYTES) != hipSuccess || per_cu < 1) per_cu = 1;
        (void)hipGetLastError();
        grid_blocks = cus * per_cu;
    }
    if (grid_blocks < 0) return;
    Params p{};
    p.x = (const float*)d_in[0]; p.c = (const float*)d_in[1]; p.ctx = (const float*)d_in[2]; p.c_ctx = (const float*)d_in[3];
    p.w_mod = (const float*)d_in[4]; p.b_mod = (const float*)d_in[5]; p.norm_g = (const float*)d_in[6];
    p.ab_w_in = (const float*)d_in[7]; p.ab_w_out = (const float*)d_in[8]; p.ret_decay = (const float*)d_in[9]; p.swa_sink = (const float*)d_in[10];
    p.na_w_in = (const float*)d_in[11]; p.na_w_out = (const float*)d_in[12]; p.na_rpb = (const float*)d_in[13];
    p.ffn_w_up = (const float*)d_in[14]; p.ffn_conv_w = (const float*)d_in[15]; p.ffn_conv_b = (const float*)d_in[16]; p.ffn_w_down = (const float*)d_in[17];
    p.out = (float*)d_out; p.ws = (unsigned char*)d_ws;
    if (hipMemsetAsync((unsigned char*)d_ws + WS_BAR, 0, 16384, stream) != hipSuccess) { fprintf(stderr, "kernel_launch: memset of barrier words failed\n"); return; }
    void* args[] = {&p};
    hipError_t e = hipLaunchCooperativeKernel((const void*)hybrid_fwd_megakernel, dim3(grid_blocks), dim3(NTHREADS), args, LDS_BYTES, stream);
    if (e != hipSuccess) fprintf(stderr, "cooperative launch failed: %s (grid %d)\n", hipGetErrorString(e), grid_blocks);
}
```

```cpp
#include <hip/hip_runtime.h>
#include <hip/hip_cooperative_groups.h>
#include <cstdio>
namespace cg = cooperative_groups;

#define LAS __attribute__((address_space(3)))
typedef unsigned short bf16_t;
typedef short bf16x8 __attribute__((ext_vector_type(8)));
typedef short s16x4 __attribute__((ext_vector_type(4)));
typedef float f32x4 __attribute__((ext_vector_type(4)));
typedef float f32x2 __attribute__((ext_vector_type(2)));
typedef unsigned u32x4 __attribute__((ext_vector_type(4)));
typedef unsigned u32x2 __attribute__((ext_vector_type(2)));

constexpr int DM = 1024, NBATCH = 32, SEQL = 2048, CTXL = 256;
constexpr int ML = NBATCH * SEQL;
constexpr int MC = NBATCH * CTXL;
constexpr int MT = ML + MC;
constexpr int ABIN = 2816, DFF = 2816, NUP = 5632, NA3 = 3072;
constexpr int NTHREADS = 512;
constexpr int LDS_BYTES = 147456;
constexpr float EPSN = 1e-6f;

constexpr size_t WS_H    = 0;
constexpr size_t WS_PX   = WS_H + (size_t)MT * 1024 * 2;
constexpr size_t WS_Y    = WS_PX + (size_t)MT * 3072 * 2;
constexpr size_t WS_OX   = WS_Y + (size_t)MT * 1024 * 2;
constexpr size_t WS_CTX  = WS_OX + (size_t)MT * 1024 * 2;
constexpr size_t WS_WABI = WS_CTX + (size_t)MC * 1024 * 4;
constexpr size_t WS_WABO = WS_WABI + (size_t)2816 * 1024 * 2;
constexpr size_t WS_WNAI = WS_WABO + (size_t)1024 * 1024 * 2;
constexpr size_t WS_WNAO = WS_WNAI + (size_t)3072 * 1024 * 2;
constexpr size_t WS_WUP  = WS_WNAO + (size_t)1024 * 1024 * 2;
constexpr size_t WS_WDN  = WS_WUP + (size_t)2 * 5632 * 1024 * 2;
constexpr size_t WS_MOD  = WS_WDN + (size_t)2 * 1024 * 2816 * 2;
constexpr size_t WS_RRET = WS_MOD + (size_t)2 * 33 * 6144 * 4;
constexpr size_t WS_R2D  = WS_RRET + (size_t)2048 * 64 * 8;
constexpr size_t WS_HALO = WS_R2D + (size_t)64 * 16 * 8;
constexpr size_t WS_BAR  = WS_HALO + (size_t)(MT / 64) * 4 * 704 * 16;
constexpr size_t WS_END  = WS_BAR + 16384;

struct Params {
    const float* x; const float* c; const float* ctx; const float* c_ctx; const float* w_mod; const float* b_mod; const float* norm_g;
    const float* ab_w_in; const float* ab_w_out; const float* ret_decay; const float* swa_sink;
    const float* na_w_in; const float* na_w_out; const float* na_rpb;
    const float* ffn_w_up; const float* ffn_conv_w; const float* ffn_conv_b; const float* ffn_w_down;
    float* out; unsigned char* ws;
};

__device__ __forceinline__ unsigned cvt_pk_bf16(float lo, float hi) { unsigned r; asm("v_cvt_pk_bf16_f32 %0, %1, %2" : "=v"(r) : "v"(lo), "v"(hi)); return r; }
__device__ __forceinline__ unsigned cvt_pk_bf16v(float lo, float hi) { unsigned r; asm volatile("v_cvt_pk_bf16_f32 %0, %1, %2" : "=v"(r) : "v"(lo), "v"(hi)); return r; }
__device__ __forceinline__ float bf_lo(unsigned u) { return __uint_as_float(u << 16); }
__device__ __forceinline__ float bf_hi(unsigned u) { return __uint_as_float(u & 0xffff0000u); }
__device__ __forceinline__ float wave_sum(float v) {
#pragma unroll
    for (int o = 32; o >= 1; o >>= 1) v += __shfl_xor(v, o);
    return v;
}
__device__ __forceinline__ unsigned off256(unsigned row, unsigned ch) { return 256u * row + 16u * (ch ^ (((row & 3u) << 2) | ((row >> 2) & 3u))); }
__device__ __forceinline__ unsigned off128(unsigned row, unsigned ch) { return 128u * row + 16u * (ch ^ (row & 7u)); }
__device__ __forceinline__ s16x4 tr_read(LAS unsigned char* p) { return __builtin_amdgcn_ds_read_tr16_b64_v4i16((LAS s16x4*)p); }
__device__ __forceinline__ bf16x8 cat4(s16x4 a, s16x4 b) { return __builtin_shufflevector(a, b, 0, 1, 2, 3, 4, 5, 6, 7); }
__device__ __forceinline__ bf16x8 pack8(f32x4 a, f32x4 b) {
    u32x4 w; w.x = cvt_pk_bf16(a[0], a[1]); w.y = cvt_pk_bf16(a[2], a[3]); w.z = cvt_pk_bf16(b[0], b[1]); w.w = cvt_pk_bf16(b[2], b[3]);
    return __builtin_bit_cast(bf16x8, w);
}
__device__ __forceinline__ bf16x8 pack8v(f32x4 a, f32x4 b) {
    u32x4 w; w.x = cvt_pk_bf16v(a[0], a[1]); w.y = cvt_pk_bf16v(a[2], a[3]); w.z = cvt_pk_bf16v(b[0], b[1]); w.w = cvt_pk_bf16v(b[2], b[3]);
    return __builtin_bit_cast(bf16x8, w);
}
#define MFMA16(a, b, c) __builtin_amdgcn_mfma_f32_16x16x32_bf16((a), (b), (c), 0, 0, 0)

#define XB_TMO      128
#define XB_XCNT(j)  (256  + 64 * (j))
#define XB_XSUB(j)  (1280 + 64 * (j))
#define XB_XGEN(j)  (2304 + 64 * (j))
#define XB_TOP      3328
#define XB_TOPGEN   3392
#define XCD_BAR_WORDS 3456
#define XB_SPIN_CAP (1u << 18)

__device__ __forceinline__ unsigned xb_ld(unsigned* p)              { return __hip_atomic_load(p, __ATOMIC_RELAXED, __HIP_MEMORY_SCOPE_AGENT); }
__device__ __forceinline__ unsigned xb_add(unsigned* p, unsigned v) { return __hip_atomic_fetch_add(p, v, __ATOMIC_RELAXED, __HIP_MEMORY_SCOPE_AGENT); }
__device__ __forceinline__ unsigned xb_xcc_id() { return (unsigned)__builtin_amdgcn_s_getreg((3 << 11) | 20) & 0xFu; }
#define XB_SPIN(cond, bar) do { unsigned _sp = 0; while (cond) { __builtin_amdgcn_s_sleep(1); \
    if ((++_sp & 255u) == 0u) { if (xb_ld(&(bar)[XB_TMO])) break; if (_sp > XB_SPIN_CAP) { atomicAdd(&(bar)[XB_TMO], 1u); break; } } } } while (0)

struct XcdBarrier {
    unsigned* bar; unsigned x;
    volatile LAS unsigned* st;
};

__device__ __forceinline__ XcdBarrier xcd_barrier_post(unsigned* bar, volatile LAS unsigned* st) {
    XcdBarrier b; b.bar = bar; b.x = xb_xcc_id(); b.st = st;
    if (threadIdx.x == 0) (void)xb_add(&bar[XB_XCNT(b.x)], 1u);
    return b;
}
__device__ __forceinline__ void xcd_barrier_complete(unsigned* bar, unsigned x, unsigned& nloc, unsigned& nx) {
    const unsigned G = gridDim.x * gridDim.y * gridDim.z;
    unsigned sum, cnt, mine, sp = 0u;
    for (;;) {
        sum = 0u; cnt = 0u; mine = 0u;
#pragma unroll
        for (unsigned j = 0; j < 16; ++j) { const unsigned c = xb_ld(&bar[XB_XCNT(j)]); sum += c; cnt += (c > 0u) ? 1u : 0u; mine = (j == x) ? c : mine; }
        if (sum == G) break;
        __builtin_amdgcn_s_sleep(1);
        if ((++sp & 255u) == 0u) { if (xb_ld(&bar[XB_TMO])) break; if (sp > XB_SPIN_CAP) { atomicAdd(&bar[XB_TMO], 1u); break; } }
    }
    nloc = mine > 0u ? mine : 1u; nx = cnt > 0u ? cnt : 1u;
}

__device__ __forceinline__ void xcd_barrier(const XcdBarrier& b) {
    asm volatile("s_waitcnt vmcnt(0)" ::: "memory");
    __syncthreads();
    if (threadIdx.x == 0) {
        unsigned* bar = b.bar;
        __builtin_amdgcn_s_waitcnt(0);
        unsigned nloc = b.st[0], nx = b.st[1];
        if (nloc == 0u) { xcd_barrier_complete(bar, b.x, nloc, nx); b.st[0] = nloc; b.st[1] = nx; }
        const unsigned old = xb_add(&bar[XB_XSUB(b.x)], 1u);
        const unsigned gen = old / nloc;
        if (old + 1u == (gen + 1u) * nloc) {
            __builtin_amdgcn_fence(__ATOMIC_RELEASE, "agent");
            asm volatile("s_waitcnt vmcnt(0)" ::: "memory");
            const unsigned og = xb_add(&bar[XB_TOP], 1u);
            const unsigned tg = og / nx;
            if (og + 1u == (tg + 1u) * nx) xb_add(&bar[XB_TOPGEN], 1u);
            else XB_SPIN(xb_ld(&bar[XB_TOPGEN]) == tg, bar);
            __builtin_amdgcn_fence(__ATOMIC_ACQUIRE, "agent");
            xb_add(&bar[XB_XGEN(b.x)], 1u);
            asm volatile("s_waitcnt vmcnt(0)" ::: "memory");
        } else {
            XB_SPIN(xb_ld(&bar[XB_XGEN(b.x)]) == gen, bar);
            __builtin_amdgcn_fence(__ATOMIC_ACQUIRE, "agent");
            asm volatile("s_waitcnt vmcnt(0)" ::: "memory");
        }
    }
    __syncthreads();
}

namespace pg8 {
#define PG8_LAS __attribute__((address_space(3)))
typedef unsigned short bf16_t;
typedef short bf16x8 __attribute__((ext_vector_type(8)));
typedef float f32x4 __attribute__((ext_vector_type(4)));
typedef unsigned u32x4 __attribute__((ext_vector_type(4)));
constexpr int BM = 256, BK = 64, HALF = 128, HTB = HALF * BK * 2  , STAGE_BYTES = 8 * HTB, NXCD = 8, WGM = 8;

__host__ __device__ __forceinline__ int lds_byte(int r, int c) { const int st = (r >> 4) * 2 + (c >> 5), rr = r & 15, cc = c & 31, ob = rr * 64 + cc * 2; return st * 1024 + (ob ^ (((ob >> 9) & 1) << 5)); }
__host__ __device__ __forceinline__ void stage_rc(int b, int& R, int& C) { const int st = b / 1024, sb = b % 1024, swz = sb ^ (((sb >> 9) & 1) << 5); R = (st >> 1) * 16 + swz / 64; C = (st & 1) * 32 + (swz % 64) / 2; }
__host__ __device__ __forceinline__ int perm32(int rho) { const int n = rho >> 4, i = rho & 15; return 8 * (i >> 2) + 4 * n + (i & 3); }

struct Unit { int pm, pn; };
struct Gemm { const bf16_t* A; const bf16_t* Bt; int M, N, K; };

struct StaticOrder {
    int nM, nN, nwg, G, c;
    __host__ __device__ void init(int M, int N, int G_, int c_) { nM = M / BM; nN = N / BM; nwg = nM * nN; G = G_; c = c_; }
    __host__ __device__ bool next(int i, Unit& u) const {
        const long L = (long)i * G + c; if (L >= nwg) return false;
        int wgid = (int)L; { const int q = nwg / NXCD, r = nwg % NXCD, xcd = wgid % NXCD, off = wgid / NXCD; wgid = (xcd < r ? xcd * (q + 1) : r * (q + 1) + (xcd - r) * q) + off; }
        const int nig = WGM * nN, gid = wgid / nig, fm = gid * WGM, gsz = (nM - fm) < WGM ? (nM - fm) : WGM;
        u.pm = fm + ((wgid % nig) % gsz); u.pn = (wgid % nig) / gsz; return true;
    }
    __device__ __forceinline__ void a_ready(const Unit&) const {}
    __device__ __forceinline__ void done(const Unit&) const {}
};

__device__ __forceinline__ unsigned cvt_pk_bf16(float lo, float hi) { unsigned r; asm("v_cvt_pk_bf16_f32 %0, %1, %2" : "=v"(r) : "v"(lo), "v"(hi)); return r; }
struct EpiOut {
    static constexpr bool PERM = true, AFTER_DRAIN = false;
    bf16_t* O; int ldc; int mode;
    const f32x4* rret; const f32x4* r2d;
    __device__ __forceinline__ void operator()(const f32x4 (&acc)[2][2][4][2], const Unit& u, int wr, int wc, int fr, int fq) const {
        const int row0 = u.pm * BM + wr * 64 + fr;
        const int colw = wc * 32 + 8 * fq;
        const bool lat = (u.pm < 256);
#pragma unroll
        for (int bj = 0; bj < 2; ++bj) {
            const int colbase = u.pn * BM + bj * HALF;
            const int col0 = colbase + colw;
            int kind = 0; float scale = 1.f;
            if (mode == 1) {
                if (colbase < 512) { kind = 1; }
                else if (colbase < 1024) { kind = 1; scale = 0.08838834764831845f; }
                else if (colbase < 2048) { }
                else if (colbase < 2560) { kind = 2; scale = 0.18033688011112042f; }
                else if (colbase < 2688) { kind = 2; }
            } else if (mode == 2) { if (colbase < 1024) scale = 0.18033688011112042f; }
            if (!lat) kind = 0;
#pragma unroll
            for (int ai = 0; ai < 2; ++ai)
#pragma unroll
                for (int m = 0; m < 4; ++m) {
                    const int row = row0 + ai * HALF + m * 16;
                    f32x4 v0 = acc[ai][bj][m][0] * scale, v1 = acc[ai][bj][m][1] * scale;
                    if (kind != 0) {
                        const int t = row & 2047;
                        const f32x4* tp;
                        if (kind == 1) tp = rret + ((t * 64 + ((col0 & 127) >> 1)) >> 1);
                        else { const int i0 = (col0 & 63) >> 1; const int pos = i0 < 16 ? (t >> 6) : (t & 63); tp = r2d + ((pos * 16 + (i0 & 15)) >> 1); }
                        const f32x4 cs0 = tp[0], cs1 = tp[1];
                        float a, b;
                        a = v0[0]; b = v0[1]; v0[0] = a * cs0[0] - b * cs0[1]; v0[1] = a * cs0[1] + b * cs0[0];
                        a = v0[2]; b = v0[3]; v0[2] = a * cs0[2] - b * cs0[3]; v0[3] = a * cs0[3] + b * cs0[2];
                        a = v1[0]; b = v1[1]; v1[0] = a * cs1[0] - b * cs1[1]; v1[1] = a * cs1[1] + b * cs1[0];
                        a = v1[2]; b = v1[3]; v1[2] = a * cs1[2] - b * cs1[3]; v1[3] = a * cs1[3] + b * cs1[2];
                    }
                    u32x4 w; w.x = cvt_pk_bf16(v0[0], v0[1]); w.y = cvt_pk_bf16(v0[2], v0[3]); w.z = cvt_pk_bf16(v1[0], v1[1]); w.w = cvt_pk_bf16(v1[2], v1[3]);
                    *(u32x4*)(O + (size_t)row * ldc + col0) = w;
                }
        }
    }
};


__device__ __forceinline__ float bfl(unsigned u) { return __uint_as_float(u << 16); }
__device__ __forceinline__ float bfh(unsigned u) { return __uint_as_float(u & 0xffff0000u); }
__device__ __forceinline__ float silu1(float x) { return x * __builtin_amdgcn_rcpf(1.0f + __expf(-x)); }
struct ConvW { f32x4 wa0, wa1, wa2, ba, wg0, wg1, wg2, bg; };
__device__ __forceinline__ ConvW load_convw(const float* cw, const float* cb, int q) {
    ConvW w;
    w.wa0 = *(const f32x4*)(cw + 4 * q); w.wa1 = *(const f32x4*)(cw + 5632 + 4 * q); w.wa2 = *(const f32x4*)(cw + 2 * 5632 + 4 * q); w.ba = *(const f32x4*)(cb + 4 * q);
    w.wg0 = *(const f32x4*)(cw + 2816 + 4 * q); w.wg1 = *(const f32x4*)(cw + 5632 + 2816 + 4 * q); w.wg2 = *(const f32x4*)(cw + 2 * 5632 + 2816 + 4 * q); w.bg = *(const f32x4*)(cb + 2816 + 4 * q);
    return w;
}
typedef unsigned u32x2e __attribute__((ext_vector_type(2)));
__device__ __forceinline__ u32x2e conv_act(const ConvW& w, u32x4 pv, u32x4 cv, u32x4 nv) {
    const f32x4 ap = (f32x4){bfl(pv.x), bfh(pv.x), bfl(pv.y), bfh(pv.y)}, gp = (f32x4){bfl(pv.z), bfh(pv.z), bfl(pv.w), bfh(pv.w)};
    const f32x4 ac = (f32x4){bfl(cv.x), bfh(cv.x), bfl(cv.y), bfh(cv.y)}, gc = (f32x4){bfl(cv.z), bfh(cv.z), bfl(cv.w), bfh(cv.w)};
    const f32x4 an = (f32x4){bfl(nv.x), bfh(nv.x), bfl(nv.y), bfh(nv.y)}, gn = (f32x4){bfl(nv.z), bfh(nv.z), bfl(nv.w), bfh(nv.w)};
    const f32x4 a = w.ba + w.wa0 * ap + w.wa1 * ac + w.wa2 * an;
    const f32x4 g = w.bg + w.wg0 * gp + w.wg1 * gc + w.wg2 * gn;
    u32x2e r; r.x = cvt_pk_bf16(silu1(g[0]) * a[0], silu1(g[1]) * a[1]); r.y = cvt_pk_bf16(silu1(g[2]) * a[2], silu1(g[3]) * a[3]);
    return r;
}
__device__ __forceinline__ u32x2e conv_act_c(const ConvW& w, u32x4 pv, f32x4 ac, f32x4 gc, u32x4 nv) {
    const f32x4 ap = (f32x4){bfl(pv.x), bfh(pv.x), bfl(pv.y), bfh(pv.y)}, gp = (f32x4){bfl(pv.z), bfh(pv.z), bfl(pv.w), bfh(pv.w)};
    const f32x4 an = (f32x4){bfl(nv.x), bfh(nv.x), bfl(nv.y), bfh(nv.y)}, gn = (f32x4){bfl(nv.z), bfh(nv.z), bfl(nv.w), bfh(nv.w)};
    const f32x4 a = w.ba + w.wa0 * ap + w.wa1 * ac + w.wa2 * an;
    const f32x4 g = w.bg + w.wg0 * gp + w.wg1 * gc + w.wg2 * gn;
    u32x2e r; r.x = cvt_pk_bf16(silu1(g[0]) * a[0], silu1(g[1]) * a[1]); r.y = cvt_pk_bf16(silu1(g[2]) * a[2], silu1(g[3]) * a[3]);
    return r;
}
struct EpiConv {
    static constexpr bool PERM = true, AFTER_DRAIN = false;
    bf16_t* ACT; u32x4* HALO; const float* cw; const float* cb;
    __device__ __forceinline__ void operator()(const f32x4 (&acc)[2][2][4][2], const Unit& u, int wr, int wc, int fr, int fq) const {
        const int lane = fq * 16 + fr;
        const int src_prev = (lane & 48) | ((fr + 15) & 15), src_next = (lane & 48) | ((fr + 1) & 15);
#pragma unroll
        for (int bj = 0; bj < 2; ++bj) {
            const int q = u.pn * 32 + bj * 16 + wc * 4 + fq;
            const ConvW w = load_convw(cw, cb, q);
#pragma unroll
            for (int ai = 0; ai < 2; ++ai) {
                const int rowb = u.pm * BM + ai * HALF + wr * 64;
                u32x4 P[4];
#pragma unroll
                for (int m = 0; m < 4; ++m) {
                    P[m].x = cvt_pk_bf16(acc[ai][bj][m][0][0], acc[ai][bj][m][0][1]); P[m].y = cvt_pk_bf16(acc[ai][bj][m][0][2], acc[ai][bj][m][0][3]);
                    P[m].z = cvt_pk_bf16(acc[ai][bj][m][1][0], acc[ai][bj][m][1][1]); P[m].w = cvt_pk_bf16(acc[ai][bj][m][1][2], acc[ai][bj][m][1][3]);
                }
#pragma unroll
                for (int m = 0; m < 4; ++m) {
                    const u32x4 sp = (m > 0 && fr == 15) ? P[m > 0 ? m - 1 : 0] : P[m];
                    const u32x4 sn = (m < 3 && fr == 0) ? P[m < 3 ? m + 1 : 3] : P[m];
                    u32x4 pv, nv;
                    pv.x = (unsigned)__shfl((int)sp.x, src_prev); pv.y = (unsigned)__shfl((int)sp.y, src_prev); pv.z = (unsigned)__shfl((int)sp.z, src_prev); pv.w = (unsigned)__shfl((int)sp.w, src_prev);
                    nv.x = (unsigned)__shfl((int)sn.x, src_next); nv.y = (unsigned)__shfl((int)sn.y, src_next); nv.z = (unsigned)__shfl((int)sn.z, src_next); nv.w = (unsigned)__shfl((int)sn.w, src_next);
                    const int rl = 16 * m + fr;
                    const u32x2e r = conv_act_c(w, pv, acc[ai][bj][m][0], acc[ai][bj][m][1], nv);
                    if (rl != 0 && rl != 63) *(u32x2e*)(ACT + (size_t)(rowb + rl) * 2816 + 4 * q) = r;
                    if (rl < 2 || rl >= 62) HALO[(size_t)((rowb >> 6) * 4 + (rl < 2 ? rl : rl - 60)) * 704 + q] = P[m];
                }
            }
        }
    }
};

template <class Epi, class Sched, bool STAMP = false>
__device__ __forceinline__ void gemm_phase(PG8_LAS unsigned char* lds, const Gemm g, const Sched& S, const Epi& E, unsigned long long* stamps) {
    int tid_l = threadIdx.x; asm volatile("" : "+v"(tid_l));
    const int tid = tid_l, wid = __builtin_amdgcn_readfirstlane(tid >> 6), lane = tid & 63, wr = wid >> 2, wc = wid & 3, fr = lane & 15, fq = lane >> 4;
    const int K = g.K, nt = K / BK;
    int ts_lo = 0, ts_hi = 0, nts = 0; const unsigned long long rt_entry = STAMP ? (unsigned long long)wall_clock64() : 0ull;
#define PG8_STAMP() do { if (STAMP && wid == 0 && nts < 64) { const unsigned long long _c = (unsigned long long)clock64(); \
        ts_lo = (lane == nts) ? (int)(unsigned)_c : ts_lo; ts_hi = (lane == nts) ? (int)(unsigned)(_c >> 32) : ts_hi; ++nts; } } while (0)
    PG8_STAMP();
    unsigned voffA[2], voffB[2];
#pragma unroll
    for (int i = 0; i < 2; ++i) { int R, C; stage_rc(tid * 16 + i * 8192, R, C); const int Rb = Epi::PERM ? ((R & ~31) + perm32(R & 31)) : R;
        voffA[i] = (unsigned)(R * K + C) * 2u; voffB[i] = (unsigned)(Rb * K + C) * 2u; }
    const size_t kstep = (size_t)(BK * 2);
    const size_t hstep = (size_t)HALF * K * 2;
    const size_t tstep = 2 * hstep;
    const unsigned ldsw = (unsigned)wid * 1024u;
    const int aoff = lds_byte(wr * 64 + fr, fq * 8), boff = lds_byte(wc * 32 + fr, fq * 8);
#define PG8_SA(b, h) (((b) * 2 + (h)) * HTB)
#define PG8_SB(b, h) ((4 + (b) * 2 + (h)) * HTB)
#define PG8_STAGE(bufoff, gbase, voff) do { _Pragma("unroll") for (int _i = 0; _i < 2; ++_i) \
        __builtin_amdgcn_global_load_lds((const unsigned*)((const char*)(gbase) + (voff)[_i]), (PG8_LAS unsigned*)(lds + (bufoff) + ldsw + _i * 8192), 16, 0, 0); } while (0)
#define PG8_LDA(dst, b, h) do { _Pragma("unroll") for (int m = 0; m < 4; ++m) _Pragma("unroll") for (int k = 0; k < 2; ++k) dst[m][k] = *(const PG8_LAS bf16x8*)(lds + PG8_SA(b, h) + aoff + m * 2048 + k * 1024); } while (0)
#define PG8_LDB(dst, b, h) do { _Pragma("unroll") for (int n = 0; n < 2; ++n) _Pragma("unroll") for (int k = 0; k < 2; ++k) dst[n][k] = *(const PG8_LAS bf16x8*)(lds + PG8_SB(b, h) + boff + n * 2048 + k * 1024); } while (0)
#define PG8_MMA(ai, bj, At, Bt) do { __builtin_amdgcn_s_setprio(1); _Pragma("unroll") for (int m = 0; m < 4; ++m) _Pragma("unroll") for (int n = 0; n < 2; ++n) _Pragma("unroll") for (int k = 0; k < 2; ++k) \
        acc[ai][bj][m][n] = __builtin_amdgcn_mfma_f32_16x16x32_bf16(Bt[n][k], At[m][k], acc[ai][bj][m][n], 0, 0, 0); __builtin_amdgcn_s_setprio(0); } while (0)
#define PG8_WAIT_V(n) asm volatile("s_waitcnt vmcnt(" #n ")" ::: "memory")
#define PG8_WAIT_L(n) asm volatile("s_waitcnt lgkmcnt(" #n ")" ::: "memory")
#define PG8_BAR __builtin_amdgcn_s_barrier()
#define PG8_SCHED __builtin_amdgcn_sched_barrier(0)
    Unit cur, nxt; int ui = 0;
    if (!S.next(0, cur)) return;
    f32x4 acc[2][2][4][2];
#pragma unroll
    for (int a = 0; a < 2; ++a)
#pragma unroll
        for (int b = 0; b < 2; ++b)
#pragma unroll
            for (int m = 0; m < 4; ++m)
#pragma unroll
                for (int n = 0; n < 2; ++n) acc[a][b][m][n] = (f32x4){0.f, 0.f, 0.f, 0.f};
    bf16x8 At[4][2], B0[2][2], B1[2][2];
    const char* cA = (const char*)g.A + (size_t)cur.pm * tstep; const char* cB = (const char*)g.Bt + (size_t)cur.pn * tstep;
    S.a_ready(cur);
    PG8_STAGE(PG8_SB(0, 0), cB, voffB); PG8_STAGE(PG8_SA(0, 0), cA, voffA); PG8_STAGE(PG8_SB(0, 1), cB + hstep, voffB); PG8_STAGE(PG8_SA(0, 1), cA + hstep, voffA);
    if (wr == 1) PG8_BAR;
    PG8_WAIT_V(4); PG8_BAR;
    PG8_STAGE(PG8_SB(1, 0), cB + kstep, voffB); PG8_STAGE(PG8_SA(1, 0), cA + kstep, voffA); PG8_STAGE(PG8_SB(1, 1), cB + hstep + kstep, voffB);
    PG8_WAIT_V(6); PG8_BAR;
    PG8_STAMP();
    for (;;) {
        const bool has_next = S.next(ui + 1, nxt);
        const char* nA = has_next ? (const char*)g.A + (size_t)nxt.pm * tstep : cA; const char* nB = has_next ? (const char*)g.Bt + (size_t)nxt.pn * tstep : cB;
        for (int t = 0; t < nt; t += 2) {
            const bool last = (t == nt - 2);
            const char* a1 = cA + (size_t)(t + 1) * kstep;
            const char* a2 = last ? nA : cA + (size_t)(t + 2) * kstep; const char* b2 = last ? nB : cB + (size_t)(t + 2) * kstep;
            const char* a3 = a2 + kstep; const char* b3 = b2 + kstep;
            if (last && has_next) S.a_ready(nxt);
            PG8_LDB(B0, 0, 0); PG8_SCHED; PG8_LDA(At, 0, 0); PG8_STAGE(PG8_SA(1, 1), a1 + hstep, voffA);
            PG8_WAIT_L(8); PG8_BAR; PG8_WAIT_L(0); PG8_MMA(0, 0, At, B0); PG8_BAR; PG8_SCHED;
            PG8_LDB(B1, 0, 1); PG8_STAGE(PG8_SB(0, 0), b2, voffB);
            PG8_BAR; PG8_WAIT_L(0); PG8_MMA(0, 1, At, B1); PG8_BAR;
            PG8_LDA(At, 0, 1); PG8_STAGE(PG8_SA(0, 0), a2, voffA);
            PG8_BAR; PG8_WAIT_L(0); PG8_MMA(1, 0, At, B0); PG8_BAR; PG8_SCHED;
            PG8_STAGE(PG8_SB(0, 1), b2 + hstep, voffB);
            PG8_WAIT_V(6); PG8_BAR; PG8_MMA(1, 1, At, B1); PG8_BAR;
            PG8_LDB(B0, 1, 0); PG8_SCHED; PG8_LDA(At, 1, 0); PG8_STAGE(PG8_SA(0, 1), a2 + hstep, voffA);
            PG8_WAIT_L(8); PG8_BAR; PG8_WAIT_L(0); PG8_MMA(0, 0, At, B0); PG8_BAR; PG8_SCHED;
            PG8_LDB(B1, 1, 1); PG8_STAGE(PG8_SB(1, 0), b3, voffB);
            PG8_BAR; PG8_WAIT_L(0); PG8_MMA(0, 1, At, B1); PG8_BAR;
            PG8_LDA(At, 1, 1); PG8_STAGE(PG8_SA(1, 0), a3, voffA);
            PG8_BAR; PG8_WAIT_L(0); PG8_MMA(1, 0, At, B0); PG8_BAR; PG8_SCHED;
            PG8_STAGE(PG8_SB(1, 1), b3 + hstep, voffB);
            PG8_WAIT_V(6); PG8_BAR; PG8_MMA(1, 1, At, B1); PG8_BAR;
        }
        PG8_STAMP();
        if constexpr (!Epi::AFTER_DRAIN) { E(acc, cur, wr, wc, fr, fq); S.done(cur); }
        PG8_STAMP();
        if (!has_next) break;
#pragma unroll
        for (int a = 0; a < 2; ++a)
#pragma unroll
            for (int b = 0; b < 2; ++b)
#pragma unroll
                for (int m = 0; m < 4; ++m)
#pragma unroll
                    for (int n = 0; n < 2; ++n) acc[a][b][m][n] = (f32x4){0.f, 0.f, 0.f, 0.f};
        cur = nxt; cA = nA; cB = nB; ++ui;
    }
    PG8_WAIT_V(0);
    if (wr == 0) PG8_BAR;
    PG8_BAR;
    if constexpr (Epi::AFTER_DRAIN) { E.fused(acc, cur, wr, wc, fr, fq, lds, wid, lane); S.done(cur); }
    PG8_STAMP();
    if (STAMP && wid == 0) { stamps[lane] = lane < nts ? (((unsigned long long)(unsigned)ts_hi << 32) | (unsigned)ts_lo) : 0ull;
        if (lane == 62) stamps[62] = rt_entry; if (lane == 63) stamps[63] = (unsigned long long)wall_clock64(); }
#undef PG8_STAMP
#undef PG8_SA
#undef PG8_SB
#undef PG8_STAGE
#undef PG8_LDA
#undef PG8_LDB
#undef PG8_MMA
#undef PG8_WAIT_V
#undef PG8_WAIT_L
#undef PG8_BAR
#undef PG8_SCHED
}
}

__device__ __forceinline__ int tid_fresh() { int t = threadIdx.x; asm volatile("" : "+v"(t)); return t; }
__device__ __forceinline__ int perm_ab(int p) {
    if (p < 1024) { const int h = p >> 7, q = p & 127; return (h << 7) + (q >> 1) + ((q & 1) << 6); }
    if (p < 2048) return p;
    if (p < 2688) { const int hb = p & ~63, q = p & 63, i = q >> 1; return hb + (i < 16 ? i : 16 + i) + ((q & 1) << 4); }
    return p;
}
__device__ __forceinline__ int perm_up(int p) { const int q = p >> 3, e = p & 7; return e < 4 ? 4 * q + e : DFF + 4 * q + (e - 4); }

struct TrJob { const float* W; bf16_t* Wt; int K, N, ptype, tile; };
__device__ __forceinline__ TrJob tr_job(const Params& p, unsigned char* ws, int t) {
    TrJob j;
    if (t < 704) { j.W = p.ab_w_in; j.K = 1024; j.N = 2816; j.Wt = (bf16_t*)(ws + WS_WABI); j.ptype = 1; j.tile = t; }
    else if (t < 960) { j.W = p.ab_w_out; j.K = 1024; j.N = 1024; j.Wt = (bf16_t*)(ws + WS_WABO); j.ptype = 0; j.tile = t - 704; }
    else if (t < 1728) { j.W = p.na_w_in; j.K = 1024; j.N = 3072; j.Wt = (bf16_t*)(ws + WS_WNAI); j.ptype = 0; j.tile = t - 960; }
    else if (t < 1984) { j.W = p.na_w_out; j.K = 1024; j.N = 1024; j.Wt = (bf16_t*)(ws + WS_WNAO); j.ptype = 0; j.tile = t - 1728; }
    else if (t < 3392) { j.W = p.ffn_w_up; j.K = 1024; j.N = 5632; j.Wt = (bf16_t*)(ws + WS_WUP); j.ptype = 2; j.tile = t - 1984; }
    else if (t < 4800) { j.W = p.ffn_w_up + (size_t)1024 * 5632; j.K = 1024; j.N = 5632; j.Wt = (bf16_t*)(ws + WS_WUP) + (size_t)5632 * 1024; j.ptype = 2; j.tile = t - 3392; }
    else if (t < 5504) { j.W = p.ffn_w_down; j.K = 2816; j.N = 1024; j.Wt = (bf16_t*)(ws + WS_WDN); j.ptype = 0; j.tile = t - 4800; }
    else { j.W = p.ffn_w_down + (size_t)2816 * 1024; j.K = 2816; j.N = 1024; j.Wt = (bf16_t*)(ws + WS_WDN) + (size_t)1024 * 2816; j.ptype = 0; j.tile = t - 5504; }
    return j;
}
__device__ __forceinline__ void tr_load(const TrJob& j, int tid, float (&v)[8]) {
    const int ntn = j.N >> 6;
    const int tk = j.tile / ntn, tn = j.tile - tk * ntn;
    const int jj = tid & 63, i0 = tid >> 6, n = tn * 64 + jj;
    const int ncol = j.ptype == 1 ? perm_ab(n) : (j.ptype == 2 ? perm_up(n) : n);
    const float* src = j.W + (size_t)(tk * 64 + i0) * j.N + ncol;
#pragma unroll
    for (int ii = 0; ii < 8; ++ii) v[ii] = src[(size_t)(8 * ii) * j.N];
}
__device__ __forceinline__ void tr_store(const TrJob& j, int tid, const float (&v)[8], LAS float* T) {
    const int ntn = j.N >> 6;
    const int tk = j.tile / ntn, tn = j.tile - tk * ntn;
    {
        const int jj = tid & 63, i0 = tid >> 6;
#pragma unroll
        for (int ii = 0; ii < 8; ++ii) T[jj * 65 + i0 + 8 * ii] = v[ii];
    }
    __syncthreads();
    {
        const int r = tid >> 3, c = tid & 7;
        LAS float* s = T + r * 65 + c * 8;
        u32x4 w; w.x = cvt_pk_bf16(s[0], s[1]); w.y = cvt_pk_bf16(s[2], s[3]); w.z = cvt_pk_bf16(s[4], s[5]); w.w = cvt_pk_bf16(s[6], s[7]);
        *(u32x4*)(j.Wt + (size_t)(tn * 64 + r) * j.K + tk * 64 + c * 8) = w;
    }
    __syncthreads();
}

__device__ __forceinline__ void prep_phase(const Params& p, LAS unsigned char* lds) {
    unsigned char* ws = p.ws;
    const int tid = tid_fresh(), lane = tid & 63, w = tid >> 6;
    {
        f32x2* rret = (f32x2*)(ws + WS_RRET); f32x2* r2d = (f32x2*)(ws + WS_R2D);
        for (int idx = blockIdx.x * NTHREADS + tid; idx < 2048 * 64 + 64 * 16; idx += gridDim.x * NTHREADS) {
            if (idx < 2048 * 64) { const int t = idx >> 6, i = idx & 63; const float inv = powf(10000.0f, -(float)i / 64.0f); const float ang = (float)t * inv; f32x2 v; v.x = cosf(ang); v.y = sinf(ang); rret[idx] = v; }
            else { const int j = idx - 2048 * 64, pos = j >> 4, i = j & 15; const float inv = powf(10000.0f, -(float)i / 16.0f); const float ang = (float)pos * inv; f32x2 v; v.x = cosf(ang); v.y = sinf(ang); r2d[j] = v; }
        }
    }
    {
        LAS float* sil = (LAS float*)lds;
        float* mod = (float*)(ws + WS_MOD);
        for (int it = (int)gridDim.x - 1 - (int)blockIdx.x; it < 192; it += gridDim.x) {
            __syncthreads();
            for (int idx = tid; idx < 33 * 1024; idx += NTHREADS) { const float v = idx < 32 * 1024 ? p.c[idx] : p.c_ctx[idx - 32 * 1024]; sil[idx] = v / (1.0f + expf(-v)); }
            __syncthreads();
            const int l = it / 96, col0 = (it % 96) * 64;
            const float* wm = p.w_mod + (size_t)l * 1024 * 6144 + col0 + lane;
            float acc[33];
#pragma unroll
            for (int r = 0; r < 33; ++r) acc[r] = 0.f;
            float wn[8];
#pragma unroll
            for (int u = 0; u < 8; ++u) wn[u] = wm[(size_t)(w * 128 + u) * 6144];
            for (int k0 = w * 128; k0 < w * 128 + 128; k0 += 8) {
                float wv[8];
#pragma unroll
                for (int u = 0; u < 8; ++u) wv[u] = wn[u];
                if (k0 + 8 < w * 128 + 128) {
#pragma unroll
                    for (int u = 0; u < 8; ++u) wn[u] = wm[(size_t)(k0 + 8 + u) * 6144];
                }
#pragma unroll
                for (int r = 0; r < 33; ++r) {
                    const f32x4 s0 = *(LAS f32x4*)(sil + r * 1024 + k0), s1 = *(LAS f32x4*)(sil + r * 1024 + k0 + 4);
                    acc[r] += s0[0] * wv[0] + s0[1] * wv[1] + s0[2] * wv[2] + s0[3] * wv[3] + s1[0] * wv[4] + s1[1] * wv[5] + s1[2] * wv[6] + s1[3] * wv[7];
                }
            }
            __syncthreads();
            LAS float* red = (LAS float*)lds;
#pragma unroll
            for (int r = 0; r < 33; ++r) red[(w * 33 + r) * 64 + lane] = acc[r];
            __syncthreads();
            for (int idx = tid; idx < 33 * 64; idx += NTHREADS) {
                const int r = idx >> 6, cc = idx & 63;
                float s = p.b_mod[l * 6144 + col0 + cc];
#pragma unroll
                for (int ww = 0; ww < 8; ++ww) s += red[(ww * 33 + r) * 64 + cc];
                mod[(size_t)(l * 33 + r) * 6144 + col0 + cc] = s;
            }
        }
        __syncthreads();
    }
    {
        LAS float* T = (LAS float*)lds;
        const int G = (int)gridDim.x;
        int t = blockIdx.x;
        if (t < 6208) {
            float curA[8], curB[8], nxtA[8], nxtB[8];
            TrJob jA = tr_job(p, ws, t), jB = jA;
            bool hasB = t + G < 6208;
            tr_load(jA, tid, curA);
            if (hasB) { jB = tr_job(p, ws, t + G); tr_load(jB, tid, curB); }
            for (;;) {
                const int tnA = t + 2 * G, tnB = t + 3 * G;
                const bool nA = tnA < 6208, nB = tnB < 6208;
                TrJob jnA = jA, jnB = jB;
                if (nA) { jnA = tr_job(p, ws, tnA); tr_load(jnA, tid, nxtA); }
                if (nB) { jnB = tr_job(p, ws, tnB); tr_load(jnB, tid, nxtB); }
                tr_store(jA, tid, curA, T);
                if (hasB) tr_store(jB, tid, curB, T);
                if (!nA) break;
#pragma unroll
                for (int i = 0; i < 8; ++i) { curA[i] = nxtA[i]; curB[i] = nxtB[i]; }
                jA = jnA; jB = jnB; hasB = nB; t = tnA;
            }
        }
    }
}

__device__ __forceinline__ void rowwise_phase(const float* xin_lat, const float* xin_ctx, float* xout_lat, float* xout_ctx, const bf16_t* ox,
                                           const float* gpost, const float* modgate, const float* gpre, const float* modshift, const float* modscale, bf16_t* H, int nrows) {
    const int tid = tid_fresh(), lane = tid & 63, gw = blockIdx.x * 8 + (tid >> 6), nw = gridDim.x * 8;
    for (int grp = gw; grp * 4 < nrows; grp += nw) {
        const int rowb = grp * 4;
        const bool lat = rowb < ML; const int mrow = lat ? (rowb >> 11) : 32;
        const float* xi = lat ? xin_lat + (size_t)rowb * 1024 : xin_ctx + (size_t)(rowb - ML) * 1024;
        f32x4 v[4][4]; u32x2 ob[4][4];
#pragma unroll
        for (int u = 0; u < 4; ++u) {
#pragma unroll
            for (int i = 0; i < 4; ++i) v[u][i] = __builtin_nontemporal_load((const f32x4*)(xi + u * 1024 + lane * 4 + 256 * i));
            if (ox) {
#pragma unroll
                for (int i = 0; i < 4; ++i) ob[u][i] = *(const u32x2*)(ox + (size_t)(rowb + u) * 1024 + lane * 4 + 256 * i);
            }
        }
        if (ox) {
            f32x4 gg[4];
            const float* gate = modgate + (size_t)mrow * 6144;
#pragma unroll
            for (int i = 0; i < 4; ++i) { const int col = lane * 4 + 256 * i; gg[i] = *(const f32x4*)(gpost + col) * *(const f32x4*)(gate + col); }
            float* xo = lat ? xout_lat + (size_t)rowb * 1024 : xout_ctx + (size_t)(rowb - ML) * 1024;
#pragma unroll
            for (int u = 0; u < 4; ++u) {
                f32x4 o[4]; float ss = 0.f;
#pragma unroll
                for (int i = 0; i < 4; ++i) {
                    const u32x2 t = ob[u][i];
                    o[i] = (f32x4){bf_lo(t.x), bf_hi(t.x), bf_lo(t.y), bf_hi(t.y)};
                    ss += o[i][0] * o[i][0] + o[i][1] * o[i][1] + o[i][2] * o[i][2] + o[i][3] * o[i][3];
                }
                ss = wave_sum(ss);
                const float rinv = rsqrtf(ss * (1.0f / 1024.0f) + EPSN);
#pragma unroll
                for (int i = 0; i < 4; ++i) {
                    v[u][i] += (o[i] * rinv) * gg[i];
                    __builtin_nontemporal_store(v[u][i], (f32x4*)(xo + u * 1024 + lane * 4 + 256 * i));
                }
            }
        }
        if (H) {
            f32x4 g2[4], s1[4], s0[4];
            const float* sh = modshift + (size_t)mrow * 6144; const float* sc = modscale + (size_t)mrow * 6144;
#pragma unroll
            for (int i = 0; i < 4; ++i) { const int col = lane * 4 + 256 * i; s1[i] = *(const f32x4*)(sc + col) + 1.0f; g2[i] = *(const f32x4*)(gpre + col) * s1[i]; s0[i] = *(const f32x4*)(sh + col); }
#pragma unroll
            for (int u = 0; u < 4; ++u) {
                float ss = 0.f;
#pragma unroll
                for (int i = 0; i < 4; ++i) ss += v[u][i][0] * v[u][i][0] + v[u][i][1] * v[u][i][1] + v[u][i][2] * v[u][i][2] + v[u][i][3] * v[u][i][3];
                ss = wave_sum(ss);
                const float rinv = rsqrtf(ss * (1.0f / 1024.0f) + EPSN);
#pragma unroll
                for (int i = 0; i < 4; ++i) {
                    const f32x4 h = (v[u][i] * rinv) * g2[i] + s0[i];
                    u32x2 wv; wv.x = cvt_pk_bf16(h[0], h[1]); wv.y = cvt_pk_bf16(h[2], h[3]);
                    *(u32x2*)(H + (size_t)(rowb + u) * 1024 + lane * 4 + 256 * i) = wv;
                }
            }
        }
    }
}

__device__ __forceinline__ float silu_f(float x) { return x * __builtin_amdgcn_rcpf(1.0f + __expf(-x)); }
__device__ __forceinline__ void convact_phase(const bf16_t* U, bf16_t* ACT, const float* cw, const float* cb, int row0g, int nrows) {
    const int tid = tid_fresh(), lane = tid & 63, gw = blockIdx.x * 8 + (tid >> 6), nw = gridDim.x * 8;
    const int nitems = (nrows >> 5) * 11;
    for (int it = gw; it < nitems; it += nw) {
        const int slab = it % 11, rb = it / 11;
        const int q = slab * 64 + lane;
        const f32x4 wa0 = *(const f32x4*)(cw + 4 * q), wa1 = *(const f32x4*)(cw + NUP + 4 * q), wa2 = *(const f32x4*)(cw + 2 * NUP + 4 * q), ba = *(const f32x4*)(cb + 4 * q);
        const f32x4 wg0 = *(const f32x4*)(cw + DFF + 4 * q), wg1 = *(const f32x4*)(cw + NUP + DFF + 4 * q), wg2 = *(const f32x4*)(cw + 2 * NUP + DFF + 4 * q), bg = *(const f32x4*)(cb + DFF + 4 * q);
        const int r0 = rb * 32, R0 = row0g + r0;
        const int pos0 = R0 < ML ? (R0 & 2047) : ((R0 - ML) & 255), len = R0 < ML ? 2048 : 256;
        const bf16_t* up = U + (size_t)r0 * NUP + 8 * q;
        const u32x4 zero = (u32x4){0u, 0u, 0u, 0u};
        u32x4 prev = zero, cur;
        if (pos0 > 0) prev = *(const u32x4*)(up - NUP);
        cur = *(const u32x4*)(up);
        for (int g8 = 0; g8 < 4; ++g8) {
            u32x4 nx[8];
#pragma unroll
            for (int j = 0; j < 8; ++j) { const int rr = g8 * 8 + j; nx[j] = zero; if (pos0 + rr + 1 < len) nx[j] = *(const u32x4*)(up + (size_t)(rr + 1) * NUP); }
#pragma unroll
            for (int j = 0; j < 8; ++j) {
                const int rr = g8 * 8 + j;
                const u32x4 nxt = nx[j];
                const f32x4 ap = (f32x4){bf_lo(prev.x), bf_hi(prev.x), bf_lo(prev.y), bf_hi(prev.y)}, gp = (f32x4){bf_lo(prev.z), bf_hi(prev.z), bf_lo(prev.w), bf_hi(prev.w)};
                const f32x4 ac = (f32x4){bf_lo(cur.x), bf_hi(cur.x), bf_lo(cur.y), bf_hi(cur.y)}, gc = (f32x4){bf_lo(cur.z), bf_hi(cur.z), bf_lo(cur.w), bf_hi(cur.w)};
                const f32x4 an = (f32x4){bf_lo(nxt.x), bf_hi(nxt.x), bf_lo(nxt.y), bf_hi(nxt.y)}, gn = (f32x4){bf_lo(nxt.z), bf_hi(nxt.z), bf_lo(nxt.w), bf_hi(nxt.w)};
                const f32x4 a = ba + wa0 * ap + wa1 * ac + wa2 * an;
                const f32x4 g = bg + wg0 * gp + wg1 * gc + wg2 * gn;
                u32x2 wv; wv.x = cvt_pk_bf16(silu_f(g[0]) * a[0], silu_f(g[1]) * a[1]); wv.y = cvt_pk_bf16(silu_f(g[2]) * a[2], silu_f(g[3]) * a[3]);
                *(u32x2*)(ACT + (size_t)(r0 + rr) * DFF + 4 * q) = wv;
                prev = cur; cur = nxt;
            }
        }
    }
}

__device__ __forceinline__ void convfix_phase(const u32x4* HALO, bf16_t* ACT, const float* cw, const float* cb, int nblk) {
    const int tid = tid_fresh();
    const int total = nblk * 2 * 704;
    const u32x4 zero = (u32x4){0u, 0u, 0u, 0u};
    for (int it = blockIdx.x * NTHREADS + tid; it < total; it += gridDim.x * NTHREADS) {
        const int q = it % 704, rr = it / 704, kb = rr >> 1, last = rr & 1;
        const int R = kb * 64 + (last ? 63 : 0);
        const int pos = R < ML ? (R & 2047) : ((R - ML) & 255), len = R < ML ? 2048 : 256;
        u32x4 pv = zero, cv, nv = zero;
        if (!last) { cv = HALO[(size_t)(kb * 4 + 0) * 704 + q]; nv = HALO[(size_t)(kb * 4 + 1) * 704 + q]; if (pos > 0) pv = HALO[(size_t)(kb * 4 - 1) * 704 + q]; }
        else { pv = HALO[(size_t)(kb * 4 + 2) * 704 + q]; cv = HALO[(size_t)(kb * 4 + 3) * 704 + q]; if (pos < len - 1) nv = HALO[(size_t)(kb * 4 + 4) * 704 + q]; }
        const pg8::ConvW w = pg8::load_convw(cw, cb, q);
        *(pg8::u32x2e*)(ACT + (size_t)R * DFF + 4 * q) = pg8::conv_act(w, pv, cv, nv);
    }
}

__device__ __forceinline__ void combine_phase(const bf16_t* Yf, const bf16_t* Yb, const bf16_t* PX, bf16_t* Y) {
    const int tid = tid_fresh(), lane = tid & 63, gw = blockIdx.x * 8 + (tid >> 6), nw = gridDim.x * 8;
    for (int row0 = gw; row0 < MT; row0 += 4 * nw) {
        u32x4 av[4], bv[4], gv[4]; bool ok[4];
#pragma unroll
        for (int u = 0; u < 4; ++u) {
            const int row = row0 + u * nw; ok[u] = row < MT;
            const int rr = ok[u] ? row : row0;
            av[u] = *(const u32x4*)(Yf + (size_t)rr * 512 + lane * 8); bv[u] = *(const u32x4*)(Yb + (size_t)rr * 512 + lane * 8);
            gv[u] = *(const u32x4*)(PX + (size_t)rr * ABIN + 1536 + lane * 8);
        }
#pragma unroll
        for (int u = 0; u < 4; ++u) {
            if (!ok[u]) continue;
            const int row = row0 + u * nw;
            const u32x4 a = av[u], b = bv[u], g = gv[u];
            float y[8], gg[8];
            y[0] = bf_lo(a.x) + bf_lo(b.x); y[1] = bf_hi(a.x) + bf_hi(b.x); y[2] = bf_lo(a.y) + bf_lo(b.y); y[3] = bf_hi(a.y) + bf_hi(b.y);
            y[4] = bf_lo(a.z) + bf_lo(b.z); y[5] = bf_hi(a.z) + bf_hi(b.z); y[6] = bf_lo(a.w) + bf_lo(b.w); y[7] = bf_hi(a.w) + bf_hi(b.w);
            gg[0] = bf_lo(g.x); gg[1] = bf_hi(g.x); gg[2] = bf_lo(g.y); gg[3] = bf_hi(g.y); gg[4] = bf_lo(g.z); gg[5] = bf_hi(g.z); gg[6] = bf_lo(g.w); gg[7] = bf_hi(g.w);
            float ss = 0.f;
#pragma unroll
            for (int i = 0; i < 8; ++i) ss += y[i] * y[i];
            ss += __shfl_xor(ss, 1); ss += __shfl_xor(ss, 2); ss += __shfl_xor(ss, 4); ss += __shfl_xor(ss, 8);
            const float rinv = rsqrtf(ss * (1.0f / 128.0f) + EPSN);
            float o[8];
#pragma unroll
            for (int i = 0; i < 8; ++i) o[i] = y[i] * rinv * silu_f(gg[i]);
            u32x4 wv; wv.x = cvt_pk_bf16(o[0], o[1]); wv.y = cvt_pk_bf16(o[2], o[3]); wv.z = cvt_pk_bf16(o[4], o[5]); wv.w = cvt_pk_bf16(o[6], o[7]);
            *(u32x4*)(Y + (size_t)row * 1024 + lane * 8) = wv;
        }
    }
}

__device__ __forceinline__ u32x4 scale8(u32x4 v, float s) {
    u32x4 r;
    r.x = cvt_pk_bf16v(bf_lo(v.x) * s, bf_hi(v.x) * s); r.y = cvt_pk_bf16v(bf_lo(v.y) * s, bf_hi(v.y) * s);
    r.z = cvt_pk_bf16v(bf_lo(v.z) * s, bf_hi(v.z) * s); r.w = cvt_pk_bf16v(bf_lo(v.w) * s, bf_hi(v.w) * s);
    return r;
}
__device__ __forceinline__ void retention_phase(const Params& p, LAS unsigned char* lds, const bf16_t* PX, bf16_t* Yf, bf16_t* Yb) {
    const int tid = tid_fresh(), lane = tid & 63, w = __builtin_amdgcn_readfirstlane(tid >> 6), l15 = lane & 15, quad = lane >> 4, qq = l15 >> 2, pp = lane & 3;
    LAS unsigned char* Qs = lds; LAS unsigned char* Ks = lds + 32768; LAS unsigned char* Vs = lds + 65536; LAS unsigned char* As = lds + 98304;
    const unsigned fl = (((unsigned)l15 & 3u) << 2) | (((unsigned)l15 >> 2) & 3u);
    unsigned ra[4], q2a[4], q2b[4], awb, tv1, tv2, tk1b, tk2b;
#pragma unroll
    for (int ks = 0; ks < 4; ++ks) {
        ra[ks] = 256u * l15 + 16u * (((unsigned)(4 * ks + quad)) ^ fl);
        q2a[ks] = 256u * l15 + 16u * (((unsigned)(4 * ks + (quad >> 1))) ^ fl) + 8u * (quad & 1);
        q2b[ks] = 256u * l15 + 16u * (((unsigned)(4 * ks + 2 + (quad >> 1))) ^ fl) + 8u * (quad & 1);
    }
    awb = 256u * (16 * w + l15) + 16u * (((unsigned)(quad >> 1)) ^ fl) + 8u * (quad & 1);
    {
        const unsigned r1 = (unsigned)(8 * quad + qq), r2 = r1 + 4u;
        const unsigned f1 = ((r1 & 3u) << 2) | ((r1 >> 2) & 3u), f2 = ((r2 & 3u) << 2) | ((r2 >> 2) & 3u);
        tv1 = 256u * r1 + 16u * (((unsigned)(2 * w + (pp >> 1))) ^ f1) + 8u * (pp & 1);
        tv2 = 256u * r2 + 16u * (((unsigned)(2 * w + (pp >> 1))) ^ f2) + 8u * (pp & 1);
        tk1b = 256u * r1 + 16u * (((unsigned)(pp >> 1)) ^ f1) + 8u * (pp & 1); tk2b = 256u * r2 + 16u * (((unsigned)(pp >> 1)) ^ f2) + 8u * (pp & 1);
    }
    for (int item = blockIdx.x; item < 256; item += gridDim.x) {
        const int dir = item & 1, h = (item >> 1) & 3, b = item >> 3;
        const float de = p.ret_decay[dir * 4 + h];
        const float lg2 = log1pf(-exp2f(-de)) * 1.4426950408889634f;
        const float cdec = exp2f(lg2 * 128.0f);
        f32x4 S[8];
#pragma unroll
        for (int i = 0; i < 8; ++i) S[i] = (f32x4){0.f, 0.f, 0.f, 0.f};
        bf16_t* Yo = dir ? Yb : Yf;
#define RET_C0(S) ((S) < 2 ? ML + b * 256 + (dir ? 1 - (S) : (S)) * 128 : b * 2048 + (dir ? 17 - (S) : (S) - 2) * 128)
#define RET_LOAD(S) do { const int c0n_ = RET_C0(S); _Pragma("unroll") for (int c = 0; c < 4; ++c) { const int idx = tid + 512 * c, i = idx >> 4, ch = idx & 15; \
            const int tok = dir ? c0n_ + 127 - i : c0n_ + i; const bf16_t* src = PX + (size_t)tok * ABIN + h * 128 + ch * 8; \
            qn[c] = *(const u32x4*)(src); kn[c] = *(const u32x4*)(src + 512); vn[c] = *(const u32x4*)(src + 1024); } } while (0)
        u32x4 qn[4], kn[4], vn[4];
        RET_LOAD(0);
        for (int s = 0; s < 18; ++s) {
            const int c0 = RET_C0(s);
            __syncthreads();
#pragma unroll
            for (int c = 0; c < 4; ++c) {
                const int idx = tid + 512 * c, i = idx >> 4, ch = idx & 15;
                const unsigned o = off256(i, ch);
                *(LAS u32x4*)(Qs + o) = qn[c]; *(LAS u32x4*)(Vs + o) = vn[c];
                *(LAS u32x4*)(Ks + o) = scale8(kn[c], __builtin_amdgcn_exp2f(lg2 * (float)(127 - i)));
            }
            __syncthreads();
            if (s + 1 < 18) { RET_LOAD(s + 1); }
            {
                bf16x8 qf[4];
#pragma unroll
                for (int ks = 0; ks < 4; ++ks) qf[ks] = *(LAS bf16x8*)(Qs + ra[ks] + 4096u * w);
                const int i = 16 * w + l15;
                const float rowsc = __builtin_amdgcn_exp2f(lg2 * (float)(i - 127));
#pragma unroll
                for (int nt = 0; nt < 8; ++nt) {
                    f32x4 at = (f32x4){0.f, 0.f, 0.f, 0.f};
                    if (nt <= w) {
#pragma unroll
                        for (int ks = 0; ks < 4; ++ks) { const bf16x8 kf = *(LAS bf16x8*)(Ks + ra[ks] + 4096u * nt); at = MFMA16(kf, qf[ks], at); }
#pragma unroll
                        for (int jj = 0; jj < 4; ++jj) { const int diff = i - (16 * nt + 4 * quad + jj); const bool keep = dir ? (diff > 0) : (diff >= 0); at[jj] = keep ? at[jj] * rowsc : 0.f; }
                    }
                    u32x2 wv; wv.x = cvt_pk_bf16v(at[0], at[1]); wv.y = cvt_pk_bf16v(at[2], at[3]);
                    *(LAS u32x2*)(As + (awb ^ (32u * nt))) = wv;
                }
            }
            __syncthreads();
            bf16x8 vf[4], sf[4];
#pragma unroll
            for (int ks = 0; ks < 4; ++ks) {
                vf[ks] = cat4(tr_read(Vs + tv1 + 8192u * ks), tr_read(Vs + tv2 + 8192u * ks));
                sf[ks] = pack8v(S[2 * ks], S[2 * ks + 1]);
            }
#pragma unroll
            for (int it = 0; it < 8; ++it) {
                f32x4 o2 = (f32x4){0.f, 0.f, 0.f, 0.f};
#pragma unroll
                for (int pk = 0; pk < 4; ++pk) {
                    const s16x4 qa = *(LAS s16x4*)(Qs + q2a[pk] + 4096u * it);
                    const s16x4 qb = *(LAS s16x4*)(Qs + q2b[pk] + 4096u * it);
                    o2 = MFMA16(sf[pk], cat4(qa, qb), o2);
                }
                f32x4 o1 = (f32x4){0.f, 0.f, 0.f, 0.f};
#pragma unroll
                for (int ks = 0; ks < 4; ++ks) if (ks <= (it >> 1)) { const bf16x8 af = *(LAS bf16x8*)(As + ra[ks] + 4096u * it); o1 = MFMA16(vf[ks], af, o1); }
                const int i = 16 * it + l15;
                const float qd = __builtin_amdgcn_exp2f(lg2 * (float)(i + 1));
                const int tok = dir ? c0 + 127 - i : c0 + i;
                u32x2 wv; wv.x = cvt_pk_bf16v(o1[0] + qd * o2[0], o1[1] + qd * o2[1]); wv.y = cvt_pk_bf16v(o1[2] + qd * o2[2], o1[3] + qd * o2[3]);
                *(u32x2*)(Yo + (size_t)tok * 512 + h * 128 + 16 * w + 4 * quad) = wv;
            }
#pragma unroll
            for (int dt = 0; dt < 8; ++dt) {
                f32x4 acc = S[dt] * cdec;
#pragma unroll
                for (int ks = 0; ks < 4; ++ks) {
                    const bf16x8 kf = cat4(tr_read(Ks + (tk1b ^ (32u * dt)) + 8192u * ks), tr_read(Ks + (tk2b ^ (32u * dt)) + 8192u * ks));
                    acc = MFMA16(kf, vf[ks], acc);
                }
                S[dt] = acc;
            }
        }
    }
    __syncthreads();
#undef RET_C0
#undef RET_LOAD
}

__device__ __forceinline__ void swa_phase(const Params& p, LAS unsigned char* lds, const bf16_t* PX, bf16_t* Y) {
    const int tid = tid_fresh(), lane = tid & 63, w = __builtin_amdgcn_readfirstlane(tid >> 6), l15 = lane & 15, quad = lane >> 4, qq = l15 >> 2, pp = lane & 3;
    LAS unsigned char* Ks = lds; LAS unsigned char* Vs = lds + 16384;
    unsigned ka[2], va[4];
#pragma unroll
    for (int ks = 0; ks < 2; ++ks) ka[ks] = 128u * l15 + 16u * (((unsigned)(4 * ks + quad)) ^ ((unsigned)l15 & 7u));
#pragma unroll
    for (int vt = 0; vt < 4; ++vt) va[vt] = 128u * (4 * quad + qq) + 16u * (((unsigned)(2 * vt + (pp >> 1))) ^ ((unsigned)(4 * quad + qq) & 7u)) + 8u * (pp & 1);
#define SWA_MASK(IT) ((IT) >= 1024 ? 0x18u : (0x1Au | (((IT) & 15) > 0 ? 1u : 0u) | (((IT) & 15) < 15 ? 4u : 0u)))
#define SWA_PREF(IT, C) do { int b_, kvh_, qb_; if ((IT) < 1024) { qb_ = (IT) & 15; kvh_ = ((IT) >> 4) & 1; b_ = (IT) >> 5; } else { const int t_ = (IT) - 1024; qb_ = t_ & 1; kvh_ = (t_ >> 1) & 1; b_ = t_ >> 2; } \
        const size_t kr_ = (C) < 3 ? (size_t)b_ * 2048 + (qb_ - 1 + (C)) * 128 : (size_t)ML + b_ * 256 + ((C) - 3) * 128; \
        _Pragma("unroll") for (int cc = 0; cc < 2; ++cc) { const int idx = tid + 512 * cc, j = idx >> 3, ch = idx & 7; const bf16_t* src = PX + (kr_ + j) * ABIN + 2560 + kvh_ * 64 + ch * 8; \
            kreg[cc] = *(const u32x4*)(src); vreg[cc] = *(const u32x4*)(src + 128); } } while (0)
    int item = blockIdx.x;
    if (item < 1152) {
    u32x4 kreg[2], vreg[2];
    unsigned msk = SWA_MASK(item);
    int c = __builtin_ctz(msk);
    SWA_PREF(item, c);
    for (;;) {
        const bool isctx = item >= 1024;
        int b, kvh, qb;
        if (!isctx) { qb = item & 15; kvh = (item >> 4) & 1; b = item >> 5; } else { const int t = item - 1024; qb = t & 1; kvh = (t >> 1) & 1; b = t >> 2; }
        const int qh = kvh * 4 + (w >> 1);
        const int qpos0 = qb * 128 + 64 * (w & 1);
        const size_t qrow0 = isctx ? (size_t)ML + b * 256 + qpos0 : (size_t)b * 2048 + qpos0;
        bf16x8 qf[4][2];
#pragma unroll
        for (int it = 0; it < 4; ++it)
#pragma unroll
            for (int ks = 0; ks < 2; ++ks) qf[it][ks] = *(const bf16x8*)(PX + (qrow0 + 16 * it + l15) * ABIN + 2048 + qh * 64 + 32 * ks + 8 * quad);
        const float sink = p.swa_sink[qh] * 1.4426950408889634f;
        float mrun[4], lrun[4]; f32x4 o[4][4];
#pragma unroll
        for (int it = 0; it < 4; ++it) { mrun[it] = sink; lrun[it] = 0.f;
#pragma unroll
            for (int vt = 0; vt < 4; ++vt) o[vt][it] = (f32x4){0.f, 0.f, 0.f, 0.f}; }
        const int nxt_item = item + (int)gridDim.x;
        for (;;) {
            const bool local = c < 3;
            const int kstart = (qb - 1 + c) * 128;
            __syncthreads();
#pragma unroll
            for (int cc = 0; cc < 2; ++cc) { const int idx = tid + 512 * cc, j = idx >> 3, ch = idx & 7; *(LAS u32x4*)(Ks + off128(j, ch)) = kreg[cc]; *(LAS u32x4*)(Vs + off128(j, ch)) = vreg[cc]; }
            __syncthreads();
            const unsigned rest = msk & ~((2u << c) - 1u);
            int nc = 0;
            if (rest) { nc = __builtin_ctz(rest); SWA_PREF(item, nc); }
            else if (nxt_item < 1152) { nc = __builtin_ctz(SWA_MASK(nxt_item)); SWA_PREF(nxt_item, nc); }
            for (int kk = 0; kk < 4; ++kk) {
                const int g0 = kstart + 32 * kk;
                if (local && (g0 + 31 < qpos0 - 128 || g0 > qpos0 + 63 + 128)) continue;
                const bool needmask = local && !(g0 >= qpos0 - 65 && g0 + 31 <= qpos0 + 128);
                f32x4 st[4][2];
#pragma unroll
                for (int it = 0; it < 4; ++it) { st[it][0] = (f32x4){0.f, 0.f, 0.f, 0.f}; st[it][1] = (f32x4){0.f, 0.f, 0.f, 0.f}; }
#pragma unroll
                for (int jt = 0; jt < 2; ++jt)
#pragma unroll
                    for (int ks = 0; ks < 2; ++ks) {
                        const bf16x8 kf = *(LAS bf16x8*)(Ks + ka[ks] + 128u * (32 * kk + 16 * jt));
#pragma unroll
                        for (int it = 0; it < 4; ++it) st[it][jt] = MFMA16(kf, qf[it][ks], st[it][jt]);
                    }
                bf16x8 pf[4];
#pragma unroll
                for (int it = 0; it < 4; ++it) {
                    float mx = -1e30f;
                    if (needmask) {
                        const int qpos = qpos0 + 16 * it + l15;
#pragma unroll
                        for (int jt = 0; jt < 2; ++jt)
#pragma unroll
                            for (int jj = 0; jj < 4; ++jj) { const int d = qpos - (g0 + 16 * jt + 4 * quad + jj); if (d > 128 || d < -128) st[it][jt][jj] = -1e30f; }
                    }
#pragma unroll
                    for (int jt = 0; jt < 2; ++jt)
#pragma unroll
                        for (int jj = 0; jj < 4; ++jj) mx = fmaxf(mx, st[it][jt][jj]);
                    mx = fmaxf(mx, __shfl_xor(mx, 16)); mx = fmaxf(mx, __shfl_xor(mx, 32));
                    const float mnew = fmaxf(mrun[it], mx);
                    const float sc = __builtin_amdgcn_exp2f(mrun[it] - mnew);
                    float ps = 0.f;
#pragma unroll
                    for (int jt = 0; jt < 2; ++jt)
#pragma unroll
                        for (int jj = 0; jj < 4; ++jj) { const float e = __builtin_amdgcn_exp2f(st[it][jt][jj] - mnew); st[it][jt][jj] = e; ps += e; }
                    lrun[it] = lrun[it] * sc + ps; mrun[it] = mnew;
                    if (__builtin_amdgcn_ballot_w64(sc < 1.0f) != 0ull) {
#pragma unroll
                        for (int vt = 0; vt < 4; ++vt) o[vt][it] *= sc;
                    }
                    pf[it] = pack8(st[it][0], st[it][1]);
                }
#pragma unroll
                for (int vt = 0; vt < 4; ++vt) {
                    const bf16x8 vf = cat4(tr_read(Vs + va[vt] + 128u * (32 * kk)), tr_read(Vs + va[vt] + 128u * (32 * kk + 16)));
#pragma unroll
                    for (int it = 0; it < 4; ++it) o[vt][it] = MFMA16(vf, pf[it], o[vt][it]);
                }
            }
            if (!rest) { c = nc; break; }
            c = nc;
        }
#pragma unroll
        for (int it = 0; it < 4; ++it) {
            float lt = lrun[it]; lt += __shfl_xor(lt, 16); lt += __shfl_xor(lt, 32);
            lt += __builtin_amdgcn_exp2f(sink - mrun[it]);
            const float inv = 1.0f / lt;
            bf16_t* dst = Y + (qrow0 + 16 * it + l15) * 1024 + 512 + qh * 64 + 4 * quad;
#pragma unroll
            for (int vt = 0; vt < 4; ++vt) { u32x2 wv; wv.x = cvt_pk_bf16(o[vt][it][0] * inv, o[vt][it][1] * inv); wv.y = cvt_pk_bf16(o[vt][it][2] * inv, o[vt][it][3] * inv); *(u32x2*)(dst + 16 * vt) = wv; }
        }
        item = nxt_item;
        if (item >= 1152) break;
        msk = SWA_MASK(item);
    }
    }
#undef SWA_MASK
#undef SWA_PREF
    __syncthreads();
}

__device__ __forceinline__ void na_phase(const Params& p, LAS unsigned char* lds, const bf16_t* QKV, bf16_t* Y) {
    const int tid = tid_fresh(), lane = tid & 63, w = __builtin_amdgcn_readfirstlane(tid >> 6), l15 = lane & 15, quad = lane >> 4, qq = l15 >> 2, pp = lane & 3;
    LAS unsigned char* Ks = lds; LAS unsigned char* Vs = lds + 32768; LAS float* rp = (LAS float*)(lds + 65536);
    const int hh = w >> 2, m = w & 3;
    const int pq = ((quad & 1) << 1) | (quad >> 1);
    const int kl = (((((l15 >> 2) & 1) << 1) | (l15 >> 3)) << 2) | (l15 & 3);
    const int sup0 = min(max(16 * m - 8, 0), 32);
    const int qc = 16 * m + l15, qstart = min(max(qc - 8, 0), 48);
    unsigned kaL[2], kaC[2], vaL[4], vaC[4];
    {
        const unsigned rl = (unsigned)(sup0 + kl), fL = ((rl & 3u) << 2) | ((rl >> 2) & 3u), rc = (unsigned)kl, fC = ((rc & 3u) << 2) | ((rc >> 2) & 3u);
#pragma unroll
        for (int ks = 0; ks < 2; ++ks) { kaL[ks] = 256u * rl + 16u * (((unsigned)(8 * hh + 4 * ks + quad)) ^ fL); kaC[ks] = 256u * rc + 16u * (((unsigned)(8 * hh + 4 * ks + quad)) ^ fC); }
        const unsigned r1l = (unsigned)(sup0 + 4 * pq + qq), f1L = ((r1l & 3u) << 2) | ((r1l >> 2) & 3u), r1c = (unsigned)(4 * pq + qq), f1C = ((r1c & 3u) << 2) | ((r1c >> 2) & 3u);
#pragma unroll
        for (int vt = 0; vt < 4; ++vt) { vaL[vt] = 256u * r1l + 16u * (((unsigned)(8 * hh + 2 * vt + (pp >> 1))) ^ f1L) + 8u * (pp & 1); vaC[vt] = 256u * r1c + 16u * (((unsigned)(8 * hh + 2 * vt + (pp >> 1))) ^ f1C) + 8u * (pp & 1); }
    }
    int bofs[2][4];
#pragma unroll
    for (int jt = 0; jt < 2; ++jt)
#pragma unroll
        for (int jj = 0; jj < 4; ++jj) {
            const int kc = sup0 + 16 * jt + 4 * pq + jj;
            const bool valid = (kc >= qstart) && (kc < qstart + 16);
            bofs[jt][jj] = 4 * (hh * 480 + (valid ? (kc - qc + 15) : 31));
        }
    bool hi[4]; int bsel[4];
#pragma unroll
    for (int jj = 0; jj < 4; ++jj) {
        const int kc0 = sup0 + 4 * pq + jj;
        hi[jj] = !((kc0 >= qstart) && (kc0 < qstart + 16));
        bsel[jj] = 4 * (hh * 480 + ((hi[jj] ? kc0 + 16 : kc0) - qc + 15));
    }
    const int nitems = 8192;
    int item = blockIdx.x;
    if (item < nitems) {
        u32x4 kreg[4], vreg[4]; bf16x8 qnext[2];
        int cur_hp = -1;
#define NA_PREF(IT, C) do { const int hp_ = (IT) & 7, r_ = ((IT) >> 3) & 31, b_ = (IT) >> 8; const int rs_ = min(max(r_ - 4, 0), 24); \
        _Pragma("unroll") for (int cc = 0; cc < 4; ++cc) { const int idx = tid + 512 * cc, j = idx >> 4, ch = idx & 15; \
            const size_t tok = (C) < 4 ? (size_t)b_ * 2048 + (rs_ + 2 * (C) + (j >> 6)) * 64 + (j & 63) : (size_t)ML + b_ * 256 + ((C) - 4) * 128 + j; \
            const bf16_t* src = QKV + tok * NA3 + 1024 + hp_ * 128 + ch * 8; kreg[cc] = *(const u32x4*)(src); vreg[cc] = *(const u32x4*)(src + 1024); } } while (0)
#define NA_PREFQ(IT) do { const int hp_ = (IT) & 7, r_ = ((IT) >> 3) & 31, b_ = (IT) >> 8; const size_t qt_ = (size_t)b_ * 2048 + r_ * 64 + 16 * m + l15; \
        _Pragma("unroll") for (int ks = 0; ks < 2; ++ks) qnext[ks] = *(const bf16x8*)(QKV + qt_ * NA3 + (2 * hp_ + hh) * 64 + 32 * ks + 8 * quad); } while (0)
#define NA_STAGE(C) do { __syncthreads(); \
        if ((C) == 0 && hp != cur_hp) { for (int idx = tid; idx < 960; idx += NTHREADS) { const int hq = idx / 480, rem = idx - hq * 480, dr = rem >> 5, dc = rem & 31; rp[idx] = dc < 31 ? p.na_rpb[(2 * hp + hq) * 465 + dr * 31 + dc] * 1.4426950408889634f : -1e30f; } cur_hp = hp; } \
        _Pragma("unroll") for (int cc = 0; cc < 4; ++cc) { const int idx = tid + 512 * cc, j = idx >> 4, ch = idx & 15; *(LAS u32x4*)(Ks + off256(j, ch)) = kreg[cc]; *(LAS u32x4*)(Vs + off256(j, ch)) = vreg[cc]; } \
        __syncthreads(); } while (0)
#define NA_SOFTMAX_PV(VA, VOFF0, VOFF1) do { \
        float mx = -1e30f; \
        _Pragma("unroll") for (int gi = 0; gi < 2; ++gi) _Pragma("unroll") for (int jt = 0; jt < 2; ++jt) _Pragma("unroll") for (int jj = 0; jj < 4; ++jj) mx = fmaxf(mx, s[gi][jt][jj]); \
        mx = fmaxf(mx, __shfl_xor(mx, 16)); mx = fmaxf(mx, __shfl_xor(mx, 32)); \
        const float mnew = fmaxf(mrun, mx); const float sc = __builtin_amdgcn_exp2f(mrun - mnew); float ps = 0.f; \
        _Pragma("unroll") for (int gi = 0; gi < 2; ++gi) _Pragma("unroll") for (int jt = 0; jt < 2; ++jt) _Pragma("unroll") for (int jj = 0; jj < 4; ++jj) { const float e = __builtin_amdgcn_exp2f(s[gi][jt][jj] - mnew); s[gi][jt][jj] = e; ps += e; } \
        lrun = lrun * sc + ps; mrun = mnew; \
        _Pragma("unroll") for (int vt = 0; vt < 4; ++vt) o[vt] *= sc; \
        _Pragma("unroll") for (int gi = 0; gi < 2; ++gi) { const bf16x8 pf = pack8(s[gi][0], s[gi][1]); const unsigned vo = gi ? (VOFF1) : (VOFF0); \
            _Pragma("unroll") for (int vt = 0; vt < 4; ++vt) { const bf16x8 vf = cat4(tr_read(Vs + VA[vt] + vo), tr_read(Vs + VA[vt] + vo + 4096u)); o[vt] = MFMA16(vf, pf, o[vt]); } } } while (0)
        NA_PREF(item, 0); NA_PREFQ(item);
        for (;;) {
            const int hp = item & 7, r = (item >> 3) & 31, b = item >> 8;
            const int h = 2 * hp + hh;
            const int rs = min(max(r - 4, 0), 24);
            const size_t qtok = (size_t)b * 2048 + r * 64 + 16 * m + l15;
            bf16x8 qf[2]; qf[0] = qnext[0]; qf[1] = qnext[1];
            float mrun = -1e30f, lrun = 0.f; f32x4 o[4];
#pragma unroll
            for (int vt = 0; vt < 4; ++vt) o[vt] = (f32x4){0.f, 0.f, 0.f, 0.f};
            const int nxt_item = item + (int)gridDim.x;
            for (int c = 0; c < 4; ++c) {
                NA_STAGE(c);
                NA_PREF(item, c + 1);
                f32x4 s[2][2];
#pragma unroll
                for (int gi = 0; gi < 2; ++gi)
#pragma unroll
                    for (int jt = 0; jt < 2; ++jt) {
                        s[gi][jt] = (f32x4){0.f, 0.f, 0.f, 0.f};
#pragma unroll
                        for (int ks = 0; ks < 2; ++ks) { const bf16x8 kf = *(LAS bf16x8*)(Ks + kaL[ks] + 256u * (64 * gi + 16 * jt)); s[gi][jt] = MFMA16(kf, qf[ks], s[gi][jt]); }
                    }
                {
                    f32x4 t[2];
#pragma unroll
                    for (int gi = 0; gi < 2; ++gi) {
                        const int rowoff = 4 * ((rs + 2 * c + gi - r + 7) * 32);
#pragma unroll
                        for (int jj = 0; jj < 4; ++jj) t[gi][jj] = (hi[jj] ? s[gi][1][jj] : s[gi][0][jj]) + *(LAS float*)((LAS unsigned char*)rp + (bsel[jj] + rowoff));
                    }
                    float mx = fmaxf(fmaxf(fmaxf(t[0][0], t[0][1]), fmaxf(t[0][2], t[0][3])), fmaxf(fmaxf(t[1][0], t[1][1]), fmaxf(t[1][2], t[1][3])));
                    mx = fmaxf(mx, __shfl_xor(mx, 16)); mx = fmaxf(mx, __shfl_xor(mx, 32));
                    const float mnew = fmaxf(mrun, mx); const float sc = __builtin_amdgcn_exp2f(mrun - mnew); float ps = 0.f;
#pragma unroll
                    for (int gi = 0; gi < 2; ++gi)
#pragma unroll
                        for (int jj = 0; jj < 4; ++jj) { const float e = __builtin_amdgcn_exp2f(t[gi][jj] - mnew); ps += e; s[gi][0][jj] = hi[jj] ? 0.f : e; s[gi][1][jj] = hi[jj] ? e : 0.f; }
                    lrun = lrun * sc + ps; mrun = mnew;
#pragma unroll
                    for (int vt = 0; vt < 4; ++vt) o[vt] *= sc;
#pragma unroll
                    for (int gi = 0; gi < 2; ++gi) {
                        const bf16x8 pf = pack8(s[gi][0], s[gi][1]); const unsigned vo = gi ? 16384u : 0u;
#pragma unroll
                        for (int vt = 0; vt < 4; ++vt) { const bf16x8 vf = cat4(tr_read(Vs + vaL[vt] + vo), tr_read(Vs + vaL[vt] + vo + 4096u)); o[vt] = MFMA16(vf, pf, o[vt]); }
                    }
                }
            }
            for (int c = 4; c < 6; ++c) {
                NA_STAGE(c);
                if (c < 5) { NA_PREF(item, c + 1); }
                else if (nxt_item < nitems) { NA_PREF(nxt_item, 0); NA_PREFQ(nxt_item); }
#pragma unroll
                for (int st = 0; st < 2; ++st) {
                    f32x4 s[2][2];
#pragma unroll
                    for (int gi = 0; gi < 2; ++gi)
#pragma unroll
                        for (int jt = 0; jt < 2; ++jt) {
                            s[gi][jt] = (f32x4){0.f, 0.f, 0.f, 0.f};
#pragma unroll
                            for (int ks = 0; ks < 2; ++ks) { const bf16x8 kf = *(LAS bf16x8*)(Ks + kaC[ks] + 256u * (64 * st + 32 * gi + 16 * jt)); s[gi][jt] = MFMA16(kf, qf[ks], s[gi][jt]); }
                        }
                    NA_SOFTMAX_PV(vaC, 256u * (64 * st), 256u * (64 * st + 32));
                }
            }
            float lt = lrun; lt += __shfl_xor(lt, 16); lt += __shfl_xor(lt, 32);
            const float inv = 1.0f / lt;
            bf16_t* dst = Y + qtok * 1024 + h * 64 + 4 * quad;
#pragma unroll
            for (int vt = 0; vt < 4; ++vt) { u32x2 wv; wv.x = cvt_pk_bf16(o[vt][0] * inv, o[vt][1] * inv); wv.y = cvt_pk_bf16(o[vt][2] * inv, o[vt][3] * inv); *(u32x2*)(dst + 16 * vt) = wv; }
            item = nxt_item;
            if (item >= nitems) break;
        }
#undef NA_PREF
#undef NA_PREFQ
#undef NA_STAGE
#undef NA_SOFTMAX_PV
    }
    __syncthreads();
}


__device__ __forceinline__ void run_gemm(LAS unsigned char* lds, const bf16_t* A, const bf16_t* Bt, int M, int N, int K, bf16_t* O, int ldc, int mode, const unsigned char* ws) {
    pg8::Gemm g{A, Bt, M, N, K};
    pg8::StaticOrder S; S.init(M, N, (int)gridDim.x, (int)blockIdx.x);
    pg8::EpiOut E{O, ldc, mode, (const f32x4*)(ws + WS_RRET), (const f32x4*)(ws + WS_R2D)};
    pg8::gemm_phase<pg8::EpiOut, pg8::StaticOrder, false>(lds, g, S, E, nullptr);
}
__device__ __forceinline__ void run_gemm_conv(LAS unsigned char* lds, const bf16_t* A, const bf16_t* Bt, int M, bf16_t* ACT, u32x4* HALO, const float* cw, const float* cb) {
    pg8::Gemm g{A, Bt, M, NUP, 1024};
    pg8::StaticOrder S; S.init(M, NUP, (int)gridDim.x, (int)blockIdx.x);
    pg8::EpiConv E{ACT, (pg8::u32x4*)HALO, cw, cb};
    pg8::gemm_phase<pg8::EpiConv, pg8::StaticOrder, false>(lds, g, S, E, nullptr);
}

__global__ void __launch_bounds__(NTHREADS, 2) hybrid_fwd_megakernel(Params p) {
    extern __shared__ __attribute__((aligned(16))) unsigned char lds_raw[];
    LAS unsigned char* lds = (LAS unsigned char*)lds_raw;
    cg::grid_group grid = cg::this_grid();
    unsigned char* ws = p.ws;
    bf16_t* H = (bf16_t*)(ws + WS_H); bf16_t* PX = (bf16_t*)(ws + WS_PX); bf16_t* Y = (bf16_t*)(ws + WS_Y); bf16_t* OX = (bf16_t*)(ws + WS_OX);
    bf16_t* ACT = PX; u32x4* HALO = (u32x4*)(ws + WS_HALO); bf16_t* Yf = OX; bf16_t* Yb = OX + (size_t)MT * 512;
    float* CTXR = (float*)(ws + WS_CTX);
    const float* mod0 = (const float*)(ws + WS_MOD); const float* mod1 = mod0 + 33 * 6144;
    const bf16_t* WABI = (const bf16_t*)(ws + WS_WABI); const bf16_t* WABO = (const bf16_t*)(ws + WS_WABO);
    const bf16_t* WNAI = (const bf16_t*)(ws + WS_WNAI); const bf16_t* WNAO = (const bf16_t*)(ws + WS_WNAO);
    const bf16_t* WUP = (const bf16_t*)(ws + WS_WUP); const bf16_t* WDN = (const bf16_t*)(ws + WS_WDN);
    const float* ng0 = p.norm_g; const float* ng1 = p.norm_g + 4096;

    volatile LAS unsigned* xst = (volatile LAS unsigned*)(lds + LDS_BYTES - 16);
    if (threadIdx.x < 4) xst[threadIdx.x] = 0u;
    __syncthreads();
    const XcdBarrier xbar = xcd_barrier_post((unsigned*)(ws + WS_BAR), xst);
#define GSYNC() xcd_barrier(xbar)
#ifdef PROBE_GROUP
    unsigned long long pr_acc = 0, pr_t0 = __builtin_amdgcn_s_memrealtime();
#define PH_END(g) do { const unsigned long long t_ = __builtin_amdgcn_s_memrealtime(); if ((g) == PROBE_GROUP) pr_acc += t_ - pr_t0; pr_t0 = t_; } while (0)
#else
#define PH_END(g) do { } while (0)
#endif
    prep_phase(p, lds);
    grid.sync(); PH_END(7);
    rowwise_phase(p.x, p.ctx, nullptr, nullptr, nullptr, nullptr, nullptr, ng0, mod0, mod0 + 1024, H, MT);
    GSYNC(); PH_END(2);
    run_gemm(lds, H, WABI, MT, ABIN, 1024, PX, ABIN, 1, ws);
    GSYNC(); PH_END(1);
    retention_phase(p, lds, PX, Yf, Yb); PH_END(8);
    swa_phase(p, lds, PX, Y);
    GSYNC(); PH_END(4);
    combine_phase(Yf, Yb, PX, Y);
    GSYNC(); PH_END(5);
    run_gemm(lds, Y, WABO, MT, 1024, 1024, OX, 1024, 0, ws);
    GSYNC(); PH_END(1);
    rowwise_phase(p.x, p.ctx, p.out, CTXR, OX, ng0 + 1024, mod0 + 2 * 1024, ng0 + 2048, mod0 + 3 * 1024, mod0 + 4 * 1024, H, MT);
    GSYNC(); PH_END(2);
    run_gemm_conv(lds, H, WUP, MT, ACT, HALO, p.ffn_conv_w, p.ffn_conv_b);
    GSYNC(); PH_END(1);
    convfix_phase(HALO, ACT, p.ffn_conv_w, p.ffn_conv_b, MT / 64);
    GSYNC(); PH_END(3);
    run_gemm(lds, ACT, WDN, MT, 1024, DFF, OX, 1024, 0, ws);
    GSYNC(); PH_END(1);
    rowwise_phase(p.out, CTXR, p.out, CTXR, OX, ng0 + 3072, mod0 + 5 * 1024, ng1, mod1, mod1 + 1024, H, MT);
    GSYNC(); PH_END(2);
    run_gemm(lds, H, WNAI, ML, NA3, 1024, PX, NA3, 2, ws);
    run_gemm(lds, H + (size_t)ML * 1024, WNAI + (size_t)1024 * 1024, MC, 2048, 1024, PX + (size_t)ML * NA3 + 1024, NA3, 0, ws);
    GSYNC(); PH_END(1);
    na_phase(p, lds, PX, Y);
    GSYNC(); PH_END(6);
    run_gemm(lds, Y, WNAO, ML, 1024, 1024, OX, 1024, 0, ws);
    GSYNC(); PH_END(1);
    rowwise_phase(p.out, CTXR, p.out, CTXR, OX, ng1 + 1024, mod1 + 2 * 1024, ng1 + 2048, mod1 + 3 * 1024, mod1 + 4 * 1024, H, ML);
    GSYNC(); PH_END(2);
    run_gemm_conv(lds, H, WUP + (size_t)NUP * 1024, ML, ACT, HALO, p.ffn_conv_w + 3 * NUP, p.ffn_conv_b + NUP);
    GSYNC(); PH_END(1);
    convfix_phase(HALO, ACT, p.ffn_conv_w + 3 * NUP, p.ffn_conv_b + NUP, ML / 64);
    GSYNC(); PH_END(3);
    run_gemm(lds, ACT, WDN + (size_t)1024 * DFF, ML, 1024, DFF, OX, 1024, 0, ws);
    GSYNC(); PH_END(1);
    rowwise_phase(p.out, CTXR, p.out, CTXR, OX, ng1 + 3072, mod1 + 5 * 1024, nullptr, nullptr, nullptr, nullptr, ML);
    PH_END(2);
#ifdef PROBE_GROUP
    if (blockIdx.x == 0 && threadIdx.x == 0) { const unsigned long long te = __builtin_amdgcn_s_memrealtime(); while (__builtin_amdgcn_s_memrealtime() - te < 4ull * pr_acc) __builtin_amdgcn_s_sleep(20); }
#endif
}

extern "C" void kernel_launch(void* const* d_in, const int* in_sizes, int n_in, void* d_out, int out_size, void* d_ws, size_t ws_size, hipStream_t stream) {
    static int grid_blocks = 0;
    if (grid_blocks == 0) {
        if (n_in != 18 || ws_size < WS_END) { fprintf(stderr, "kernel_launch: unexpected n_in %d or ws_size %zu (need %zu)\n", n_in, ws_size, (size_t)WS_END); grid_blocks = -1; return; }
        int dev = 0, cus = 0, per_cu = 0;
        hipGetDevice(&dev);
        hipDeviceGetAttribute(&cus, hipDeviceAttributeMultiprocessorCount, dev);
        hipFuncSetAttribute((const void*)hybrid_fwd_megakernel, hipFuncAttributeMaxDynamicSharedMemorySize, LDS_BYTES);
        if (hipOccupancyMaxActiveBlocksPerMultiprocessor(&per_cu, (const void*)hybrid_fwd_megakernel, NTHREADS, LDS_BYTES) != hipSuccess || per_cu < 1) per_cu = 1;
        (void)hipGetLastError();
        grid_blocks = cus * per_cu;
    }
    if (grid_blocks < 0) return;
    Params p{};
    p.x = (const float*)d_in[0]; p.c = (const float*)d_in[1]; p.ctx = (const float*)d_in[2]; p.c_ctx = (const float*)d_in[3];
    p.w_mod = (const float*)d_in[4]; p.b_mod = (const float*)d_in[5]; p.norm_g = (const float*)d_in[6];
    p.ab_w_in = (const float*)d_in[7]; p.ab_w_out = (const float*)d_in[8]; p.ret_decay = (const float*)d_in[9]; p.swa_sink = (const float*)d_in[10];
    p.na_w_in = (const float*)d_in[11]; p.na_w_out = (const float*)d_in[12]; p.na_rpb = (const float*)d_in[13];
    p.ffn_w_up = (const float*)d_in[14]; p.ffn_conv_w = (const float*)d_in[15]; p.ffn_conv_b = (const float*)d_in[16]; p.ffn_w_down = (const float*)d_in[17];
    p.out = (float*)d_out; p.ws = (unsigned char*)d_ws;
    if (hipMemsetAsync((unsigned char*)d_ws + WS_BAR, 0, 16384, stream) != hipSuccess) { fprintf(stderr, "kernel_launch: memset of barrier words failed\n"); return; }
    void* args[] = {&p};
    hipError_t e = hipLaunchCooperativeKernel((const void*)hybrid_fwd_megakernel, dim3(grid_blocks), dim3(NTHREADS), args, LDS_BYTES, stream);
    if (e != hipSuccess) fprintf(stderr, "cooperative launch failed: %s (grid %d)\n", hipGetErrorString(e), grid_blocks);
}
```

```cpp
#include <hip/hip_runtime.h>
#include <hip/hip_cooperative_groups.h>
#include <cstdio>
namespace cg = cooperative_groups;

#define LAS __attribute__((address_space(3)))
typedef unsigned short bf16_t;
typedef short bf16x8 __attribute__((ext_vector_type(8)));
typedef short s16x4 __attribute__((ext_vector_type(4)));
typedef float f32x4 __attribute__((ext_vector_type(4)));
typedef float f32x2 __attribute__((ext_vector_type(2)));
typedef unsigned u32x4 __attribute__((ext_vector_type(4)));
typedef unsigned u32x2 __attribute__((ext_vector_type(2)));

constexpr int DM = 1024, NBATCH = 32, SEQL = 2048, CTXL = 256;
constexpr int ML = NBATCH * SEQL;
constexpr int MC = NBATCH * CTXL;
constexpr int MT = ML + MC;
constexpr int ABIN = 2816, DFF = 2816, NUP = 5632, NA3 = 3072;
constexpr int NTHREADS = 512;
constexpr int LDS_BYTES = 147456;
constexpr float EPSN = 1e-6f;

constexpr size_t WS_H    = 0;
constexpr size_t WS_PX   = WS_H + (size_t)MT * 1024 * 2;
constexpr size_t WS_Y    = WS_PX + (size_t)MT * 3072 * 2;
constexpr size_t WS_OX   = WS_Y + (size_t)MT * 1024 * 2;
constexpr size_t WS_CTX  = WS_OX + (size_t)MT * 1024 * 2;
constexpr size_t WS_WABI = WS_CTX + (size_t)MC * 1024 * 4;
constexpr size_t WS_WABO = WS_WABI + (size_t)2816 * 1024 * 2;
constexpr size_t WS_WNAI = WS_WABO + (size_t)1024 * 1024 * 2;
constexpr size_t WS_WNAO = WS_WNAI + (size_t)3072 * 1024 * 2;
constexpr size_t WS_WUP  = WS_WNAO + (size_t)1024 * 1024 * 2;
constexpr size_t WS_WDN  = WS_WUP + (size_t)2 * 5632 * 1024 * 2;
constexpr size_t WS_MOD  = WS_WDN + (size_t)2 * 1024 * 2816 * 2;
constexpr size_t WS_RRET = WS_MOD + (size_t)2 * 33 * 6144 * 4;
constexpr size_t WS_R2D  = WS_RRET + (size_t)2048 * 64 * 8;
constexpr size_t WS_HALO = WS_R2D + (size_t)64 * 16 * 8;
constexpr size_t WS_BAR  = WS_HALO + (size_t)(MT / 64) * 4 * 704 * 16;
constexpr size_t WS_END  = WS_BAR + 16384;

struct Params {
    const float* x; const float* c; const float* ctx; const float* c_ctx; const float* w_mod; const float* b_mod; const float* norm_g;
    const float* ab_w_in; const float* ab_w_out; const float* ret_decay; const float* swa_sink;
    const float* na_w_in; const float* na_w_out; const float* na_rpb;
    const float* ffn_w_up; const float* ffn_conv_w; const float* ffn_conv_b; const float* ffn_w_down;
    float* out; unsigned char* ws;
};

__device__ __forceinline__ unsigned cvt_pk_bf16(float lo, float hi) { unsigned r; asm("v_cvt_pk_bf16_f32 %0, %1, %2" : "=v"(r) : "v"(lo), "v"(hi)); return r; }
__device__ __forceinline__ unsigned cvt_pk_bf16v(float lo, float hi) { unsigned r; asm volatile("v_cvt_pk_bf16_f32 %0, %1, %2" : "=v"(r) : "v"(lo), "v"(hi)); return r; }
__device__ __forceinline__ float bf_lo(unsigned u) { return __uint_as_float(u << 16); }
__device__ __forceinline__ float bf_hi(unsigned u) { return __uint_as_float(u & 0xffff0000u); }
__device__ __forceinline__ float wave_sum(float v) {
#pragma unroll
    for (int o = 32; o >= 1; o >>= 1) v += __shfl_xor(v, o);
    return v;
}
__device__ __forceinline__ unsigned off256(unsigned row, unsigned ch) { return 256u * row + 16u * (ch ^ (((row & 3u) << 2) | ((row >> 2) & 3u))); }
__device__ __forceinline__ unsigned off128(unsigned row, unsigned ch) { return 128u * row + 16u * (ch ^ (row & 7u)); }
__device__ __forceinline__ s16x4 tr_read(LAS unsigned char* p) { return __builtin_amdgcn_ds_read_tr16_b64_v4i16((LAS s16x4*)p); }
__device__ __forceinline__ bf16x8 cat4(s16x4 a, s16x4 b) { return __builtin_shufflevector(a, b, 0, 1, 2, 3, 4, 5, 6, 7); }
__device__ __forceinline__ bf16x8 pack8(f32x4 a, f32x4 b) {
    u32x4 w; w.x = cvt_pk_bf16(a[0], a[1]); w.y = cvt_pk_bf16(a[2], a[3]); w.z = cvt_pk_bf16(b[0], b[1]); w.w = cvt_pk_bf16(b[2], b[3]);
    return __builtin_bit_cast(bf16x8, w);
}
__device__ __forceinline__ bf16x8 pack8v(f32x4 a, f32x4 b) {
    u32x4 w; w.x = cvt_pk_bf16v(a[0], a[1]); w.y = cvt_pk_bf16v(a[2], a[3]); w.z = cvt_pk_bf16v(b[0], b[1]); w.w = cvt_pk_bf16v(b[2], b[3]);
    return __builtin_bit_cast(bf16x8, w);
}
#define MFMA16(a, b, c) __builtin_amdgcn_mfma_f32_16x16x32_bf16((a), (b), (c), 0, 0, 0)

#define XB_TMO      128
#define XB_XCNT(j)  (256  + 64 * (j))
#define XB_XSUB(j)  (1280 + 64 * (j))
#define XB_XGEN(j)  (2304 + 64 * (j))
#define XB_TOP      3328
#define XB_TOPGEN   3392
#define XCD_BAR_WORDS 3456
#define XB_SPIN_CAP (1u << 18)

__device__ __forceinline__ unsigned xb_ld(unsigned* p)              { return __hip_atomic_load(p, __ATOMIC_RELAXED, __HIP_MEMORY_SCOPE_AGENT); }
__device__ __forceinline__ unsigned xb_add(unsigned* p, unsigned v) { return __hip_atomic_fetch_add(p, v, __ATOMIC_RELAXED, __HIP_MEMORY_SCOPE_AGENT); }
__device__ __forceinline__ unsigned xb_xcc_id() { return (unsigned)__builtin_amdgcn_s_getreg((3 << 11) | 20) & 0xFu; }
#define XB_SPIN(cond, bar) do { unsigned _sp = 0; while (cond) { __builtin_amdgcn_s_sleep(1); \
    if ((++_sp & 255u) == 0u) { if (xb_ld(&(bar)[XB_TMO])) break; if (_sp > XB_SPIN_CAP) { atomicAdd(&(bar)[XB_TMO], 1u); break; } } } } while (0)

struct XcdBarrier {
    unsigned* bar; unsigned x;
    volatile LAS unsigned* st;
};

__device__ __forceinline__ XcdBarrier xcd_barrier_post(unsigned* bar, volatile LAS unsigned* st) {
    XcdBarrier b; b.bar = bar; b.x = xb_xcc_id(); b.st = st;
    if (threadIdx.x == 0) (void)xb_add(&bar[XB_XCNT(b.x)], 1u);
    return b;
}
__device__ __forceinline__ void xcd_barrier_complete(unsigned* bar, unsigned x, unsigned& nloc, unsigned& nx) {
    const unsigned G = gridDim.x * gridDim.y * gridDim.z;
    unsigned sum, cnt, mine, sp = 0u;
    for (;;) {
        sum = 0u; cnt = 0u; mine = 0u;
#pragma unroll
        for (unsigned j = 0; j < 16; ++j) { const unsigned c = xb_ld(&bar[XB_XCNT(j)]); sum += c; cnt += (c > 0u) ? 1u : 0u; mine = (j == x) ? c : mine; }
        if (sum == G) break;
        __builtin_amdgcn_s_sleep(1);
        if ((++sp & 255u) == 0u) { if (xb_ld(&bar[XB_TMO])) break; if (sp > XB_SPIN_CAP) { atomicAdd(&bar[XB_TMO], 1u); break; } }
    }
    nloc = mine > 0u ? mine : 1u; nx = cnt > 0u ? cnt : 1u;
}

__device__ __forceinline__ void xcd_barrier(const XcdBarrier& b) {
    asm volatile("s_waitcnt vmcnt(0)" ::: "memory");
    __syncthreads();
    if (threadIdx.x == 0) {
        unsigned* bar = b.bar;
        __builtin_amdgcn_s_waitcnt(0);
        unsigned nloc = b.st[0], nx = b.st[1];
        if (nloc == 0u) { xcd_barrier_complete(bar, b.x, nloc, nx); b.st[0] = nloc; b.st[1] = nx; }
        const unsigned old = xb_add(&bar[XB_XSUB(b.x)], 1u);
        const unsigned gen = old / nloc;
        if (old + 1u == (gen + 1u) * nloc) {
            __builtin_amdgcn_fence(__ATOMIC_RELEASE, "agent");
            asm volatile("s_waitcnt vmcnt(0)" ::: "memory");
            const unsigned og = xb_add(&bar[XB_TOP], 1u);
            const unsigned tg = og / nx;
            if (og + 1u == (tg + 1u) * nx) xb_add(&bar[XB_TOPGEN], 1u);
            else XB_SPIN(xb_ld(&bar[XB_TOPGEN]) == tg, bar);
            __builtin_amdgcn_fence(__ATOMIC_ACQUIRE, "agent");
            xb_add(&bar[XB_XGEN(b.x)], 1u);
            asm volatile("s_waitcnt vmcnt(0)" ::: "memory");
        } else {
            XB_SPIN(xb_ld(&bar[XB_XGEN(b.x)]) == gen, bar);
            __builtin_amdgcn_fence(__ATOMIC_ACQUIRE, "agent");
            asm volatile("s_waitcnt vmcnt(0)" ::: "memory");
        }
    }
    __syncthreads();
}

namespace pg8 {
#define PG8_LAS __attribute__((address_space(3)))
typedef unsigned short bf16_t;
typedef short bf16x8 __attribute__((ext_vector_type(8)));
typedef float f32x4 __attribute__((ext_vector_type(4)));
typedef unsigned u32x4 __attribute__((ext_vector_type(4)));
constexpr int BM = 256, BK = 64, HALF = 128, HTB = HALF * BK * 2  , STAGE_BYTES = 8 * HTB, NXCD = 8, WGM = 8;

__host__ __device__ __forceinline__ int lds_byte(int r, int c) { const int st = (r >> 4) * 2 + (c >> 5), rr = r & 15, cc = c & 31, ob = rr * 64 + cc * 2; return st * 1024 + (ob ^ (((ob >> 9) & 1) << 5)); }
__host__ __device__ __forceinline__ void stage_rc(int b, int& R, int& C) { const int st = b / 1024, sb = b % 1024, swz = sb ^ (((sb >> 9) & 1) << 5); R = (st >> 1) * 16 + swz / 64; C = (st & 1) * 32 + (swz % 64) / 2; }
__host__ __device__ __forceinline__ int perm32(int rho) { const int n = rho >> 4, i = rho & 15; return 8 * (i >> 2) + 4 * n + (i & 3); }

struct Unit { int pm, pn; };
struct Gemm { const bf16_t* A; const bf16_t* Bt; int M, N, K; };

struct StaticOrder {
    int nM, nN, nwg, G, c;
    __host__ __device__ void init(int M, int N, int G_, int c_) { nM = M / BM; nN = N / BM; nwg = nM * nN; G = G_; c = c_; }
    __host__ __device__ bool next(int i, Unit& u) const {
        const long L = (long)i * G + c; if (L >= nwg) return false;
        int wgid = (int)L; { const int q = nwg / NXCD, r = nwg % NXCD, xcd = wgid % NXCD, off = wgid / NXCD; wgid = (xcd < r ? xcd * (q + 1) : r * (q + 1) + (xcd - r) * q) + off; }
        const int nig = WGM * nN, gid = wgid / nig, fm = gid * WGM, gsz = (nM - fm) < WGM ? (nM - fm) : WGM;
        u.pm = fm + ((wgid % nig) % gsz); u.pn = (wgid % nig) / gsz; return true;
    }
    __device__ __forceinline__ void a_ready(const Unit&) const {}
    __device__ __forceinline__ void done(const Unit&) const {}
};

__device__ __forceinline__ unsigned cvt_pk_bf16(float lo, float hi) { unsigned r; asm("v_cvt_pk_bf16_f32 %0, %1, %2" : "=v"(r) : "v"(lo), "v"(hi)); return r; }
struct EpiOut {
    static constexpr bool PERM = true, AFTER_DRAIN = false;
    bf16_t* O; int ldc; int mode;
    const f32x4* rret; const f32x4* r2d;
    __device__ __forceinline__ void operator()(const f32x4 (&acc)[2][2][4][2], const Unit& u, int wr, int wc, int fr, int fq) const {
        const int row0 = u.pm * BM + wr * 64 + fr;
        const int colw = wc * 32 + 8 * fq;
        const bool lat = (u.pm < 256);
#pragma unroll
        for (int bj = 0; bj < 2; ++bj) {
            const int colbase = u.pn * BM + bj * HALF;
            const int col0 = colbase + colw;
            int kind = 0; float scale = 1.f;
            if (mode == 1) {
                if (colbase < 512) { kind = 1; }
                else if (colbase < 1024) { kind = 1; scale = 0.08838834764831845f; }
                else if (colbase < 2048) { }
                else if (colbase < 2560) { kind = 2; scale = 0.18033688011112042f; }
                else if (colbase < 2688) { kind = 2; }
            } else if (mode == 2) { if (colbase < 1024) scale = 0.18033688011112042f; }
            if (!lat) kind = 0;
#pragma unroll
            for (int ai = 0; ai < 2; ++ai)
#pragma unroll
                for (int m = 0; m < 4; ++m) {
                    const int row = row0 + ai * HALF + m * 16;
                    f32x4 v0 = acc[ai][bj][m][0] * scale, v1 = acc[ai][bj][m][1] * scale;
                    if (kind != 0) {
                        const int t = row & 2047;
                        const f32x4* tp;
                        if (kind == 1) tp = rret + ((t * 64 + ((col0 & 127) >> 1)) >> 1);
                        else { const int i0 = (col0 & 63) >> 1; const int pos = i0 < 16 ? (t >> 6) : (t & 63); tp = r2d + ((pos * 16 + (i0 & 15)) >> 1); }
                        const f32x4 cs0 = tp[0], cs1 = tp[1];
                        float a, b;
                        a = v0[0]; b = v0[1]; v0[0] = a * cs0[0] - b * cs0[1]; v0[1] = a * cs0[1] + b * cs0[0];
                        a = v0[2]; b = v0[3]; v0[2] = a * cs0[2] - b * cs0[3]; v0[3] = a * cs0[3] + b * cs0[2];
                        a = v1[0]; b = v1[1]; v1[0] = a * cs1[0] - b * cs1[1]; v1[1] = a * cs1[1] + b * cs1[0];
                        a = v1[2]; b = v1[3]; v1[2] = a * cs1[2] - b * cs1[3]; v1[3] = a * cs1[3] + b * cs1[2];
                    }
                    u32x4 w; w.x = cvt_pk_bf16(v0[0], v0[1]); w.y = cvt_pk_bf16(v0[2], v0[3]); w.z = cvt_pk_bf16(v1[0], v1[1]); w.w = cvt_pk_bf16(v1[2], v1[3]);
                    *(u32x4*)(O + (size_t)row * ldc + col0) = w;
                }
        }
    }
};


__device__ __forceinline__ float bfl(unsigned u) { return __uint_as_float(u << 16); }
__device__ __forceinline__ float bfh(unsigned u) { return __uint_as_float(u & 0xffff0000u); }
__device__ __forceinline__ float silu1(float x) { return x * __builtin_amdgcn_rcpf(1.0f + __expf(-x)); }
struct ConvW { f32x4 wa0, wa1, wa2, ba, wg0, wg1, wg2, bg; };
__device__ __forceinline__ ConvW load_convw(const float* cw, const float* cb, int q) {
    ConvW w;
    w.wa0 = *(const f32x4*)(cw + 4 * q); w.wa1 = *(const f32x4*)(cw + 5632 + 4 * q); w.wa2 = *(const f32x4*)(cw + 2 * 5632 + 4 * q); w.ba = *(const f32x4*)(cb + 4 * q);
    w.wg0 = *(const f32x4*)(cw + 2816 + 4 * q); w.wg1 = *(const f32x4*)(cw + 5632 + 2816 + 4 * q); w.wg2 = *(const f32x4*)(cw + 2 * 5632 + 2816 + 4 * q); w.bg = *(const f32x4*)(cb + 2816 + 4 * q);
    return w;
}
typedef unsigned u32x2e __attribute__((ext_vector_type(2)));
__device__ __forceinline__ u32x2e conv_act(const ConvW& w, u32x4 pv, u32x4 cv, u32x4 nv) {
    const f32x4 ap = (f32x4){bfl(pv.x), bfh(pv.x), bfl(pv.y), bfh(pv.y)}, gp = (f32x4){bfl(pv.z), bfh(pv.z), bfl(pv.w), bfh(pv.w)};
    const f32x4 ac = (f32x4){bfl(cv.x), bfh(cv.x), bfl(cv.y), bfh(cv.y)}, gc = (f32x4){bfl(cv.z), bfh(cv.z), bfl(cv.w), bfh(cv.w)};
    const f32x4 an = (f32x4){bfl(nv.x), bfh(nv.x), bfl(nv.y), bfh(nv.y)}, gn = (f32x4){bfl(nv.z), bfh(nv.z), bfl(nv.w), bfh(nv.w)};
    const f32x4 a = w.ba + w.wa0 * ap + w.wa1 * ac + w.wa2 * an;
    const f32x4 g = w.bg + w.wg0 * gp + w.wg1 * gc + w.wg2 * gn;
    u32x2e r; r.x = cvt_pk_bf16(silu1(g[0]) * a[0], silu1(g[1]) * a[1]); r.y = cvt_pk_bf16(silu1(g[2]) * a[2], silu1(g[3]) * a[3]);
    return r;
}
__device__ __forceinline__ u32x2e conv_act_c(const ConvW& w, u32x4 pv, f32x4 ac, f32x4 gc, u32x4 nv) {
    const f32x4 ap = (f32x4){bfl(pv.x), bfh(pv.x), bfl(pv.y), bfh(pv.y)}, gp = (f32x4){bfl(pv.z), bfh(pv.z), bfl(pv.w), bfh(pv.w)};
    const f32x4 an = (f32x4){bfl(nv.x), bfh(nv.x), bfl(nv.y), bfh(nv.y)}, gn = (f32x4){bfl(nv.z), bfh(nv.z), bfl(nv.w), bfh(nv.w)};
    const f32x4 a = w.ba + w.wa0 * ap + w.wa1 * ac + w.wa2 * an;
    const f32x4 g = w.bg + w.wg0 * gp + w.wg1 * gc + w.wg2 * gn;
    u32x2e r; r.x = cvt_pk_bf16(silu1(g[0]) * a[0], silu1(g[1]) * a[1]); r.y = cvt_pk_bf16(silu1(g[2]) * a[2], silu1(g[3]) * a[3]);
    return r;
}
__device__ __forceinline__ unsigned dpp_ror1(unsigned v) { return (unsigned)__builtin_amdgcn_update_dpp(0, (int)v, 0x121, 0xf, 0xf, false); }
__device__ __forceinline__ unsigned dpp_ror15(unsigned v) { return (unsigned)__builtin_amdgcn_update_dpp(0, (int)v, 0x12F, 0xf, 0xf, false); }
struct EpiConv {
    static constexpr bool PERM = true, AFTER_DRAIN = false;
    bf16_t* ACT; u32x4* HALO; const float* cw; const float* cb;
    __device__ __forceinline__ void operator()(const f32x4 (&acc)[2][2][4][2], const Unit& u, int wr, int wc, int fr, int fq) const {
        const int lane = fq * 16 + fr;
        const int src_prev = (lane & 48) | ((fr + 15) & 15), src_next = (lane & 48) | ((fr + 1) & 15);
#pragma unroll
        for (int bj = 0; bj < 2; ++bj) {
            const int q = u.pn * 32 + bj * 16 + wc * 4 + fq;
            const ConvW w = load_convw(cw, cb, q);
#pragma unroll
            for (int ai = 0; ai < 2; ++ai) {
                const int rowb = u.pm * BM + ai * HALF + wr * 64;
                u32x4 P[4];
#pragma unroll
                for (int m = 0; m < 4; ++m) {
                    P[m].x = cvt_pk_bf16(acc[ai][bj][m][0][0], acc[ai][bj][m][0][1]); P[m].y = cvt_pk_bf16(acc[ai][bj][m][0][2], acc[ai][bj][m][0][3]);
                    P[m].z = cvt_pk_bf16(acc[ai][bj][m][1][0], acc[ai][bj][m][1][1]); P[m].w = cvt_pk_bf16(acc[ai][bj][m][1][2], acc[ai][bj][m][1][3]);
                }
                u32x4 R1[4], R15[4];
#pragma unroll
                for (int m = 0; m < 4; ++m) {
                    R1[m].x = dpp_ror1(P[m].x); R1[m].y = dpp_ror1(P[m].y); R1[m].z = dpp_ror1(P[m].z); R1[m].w = dpp_ror1(P[m].w);
                    R15[m].x = dpp_ror15(P[m].x); R15[m].y = dpp_ror15(P[m].y); R15[m].z = dpp_ror15(P[m].z); R15[m].w = dpp_ror15(P[m].w);
                }
#pragma unroll
                for (int m = 0; m < 4; ++m) {
                    const u32x4 pv = (m > 0 && fr == 0) ? R1[m > 0 ? m - 1 : 0] : R1[m];
                    const u32x4 nv = (m < 3 && fr == 15) ? R15[m < 3 ? m + 1 : 3] : R15[m];
                    const int rl = 16 * m + fr;
                    const u32x2e r = conv_act_c(w, pv, acc[ai][bj][m][0], acc[ai][bj][m][1], nv);
                    if (rl != 0 && rl != 63) *(u32x2e*)(ACT + (size_t)(rowb + rl) * 2816 + 4 * q) = r;
                    if (rl < 2 || rl >= 62) HALO[(size_t)((rowb >> 6) * 4 + (rl < 2 ? rl : rl - 60)) * 704 + q] = P[m];
                }
            }
        }
    }
};

template <class Epi, class Sched, bool STAMP = false>
__device__ __forceinline__ void gemm_phase(PG8_LAS unsigned char* lds, const Gemm g, const Sched& S, const Epi& E, unsigned long long* stamps) {
    int tid_l = threadIdx.x; asm volatile("" : "+v"(tid_l));
    const int tid = tid_l, wid = __builtin_amdgcn_readfirstlane(tid >> 6), lane = tid & 63, wr = wid >> 2, wc = wid & 3, fr = lane & 15, fq = lane >> 4;
    const int K = g.K, nt = K / BK;
    int ts_lo = 0, ts_hi = 0, nts = 0; const unsigned long long rt_entry = STAMP ? (unsigned long long)wall_clock64() : 0ull;
#define PG8_STAMP() do { if (STAMP && wid == 0 && nts < 64) { const unsigned long long _c = (unsigned long long)clock64(); \
        ts_lo = (lane == nts) ? (int)(unsigned)_c : ts_lo; ts_hi = (lane == nts) ? (int)(unsigned)(_c >> 32) : ts_hi; ++nts; } } while (0)
    PG8_STAMP();
    unsigned voffA[2], voffB[2];
#pragma unroll
    for (int i = 0; i < 2; ++i) { int R, C; stage_rc(tid * 16 + i * 8192, R, C); const int Rb = Epi::PERM ? ((R & ~31) + perm32(R & 31)) : R;
        voffA[i] = (unsigned)(R * K + C) * 2u; voffB[i] = (unsigned)(Rb * K + C) * 2u; }
    const size_t kstep = (size_t)(BK * 2);
    const size_t hstep = (size_t)HALF * K * 2;
    const size_t tstep = 2 * hstep;
    const unsigned ldsw = (unsigned)wid * 1024u;
    const int aoff = lds_byte(wr * 64 + fr, fq * 8), boff = lds_byte(wc * 32 + fr, fq * 8);
#define PG8_SA(b, h) (((b) * 2 + (h)) * HTB)
#define PG8_SB(b, h) ((4 + (b) * 2 + (h)) * HTB)
#define PG8_STAGE(bufoff, gbase, voff) do { _Pragma("unroll") for (int _i = 0; _i < 2; ++_i) \
        __builtin_amdgcn_global_load_lds((const unsigned*)((const char*)(gbase) + (voff)[_i]), (PG8_LAS unsigned*)(lds + (bufoff) + ldsw + _i * 8192), 16, 0, 0); } while (0)
#define PG8_LDA(dst, b, h) do { _Pragma("unroll") for (int m = 0; m < 4; ++m) _Pragma("unroll") for (int k = 0; k < 2; ++k) dst[m][k] = *(const PG8_LAS bf16x8*)(lds + PG8_SA(b, h) + aoff + m * 2048 + k * 1024); } while (0)
#define PG8_LDB(dst, b, h) do { _Pragma("unroll") for (int n = 0; n < 2; ++n) _Pragma("unroll") for (int k = 0; k < 2; ++k) dst[n][k] = *(const PG8_LAS bf16x8*)(lds + PG8_SB(b, h) + boff + n * 2048 + k * 1024); } while (0)
#define PG8_MMA(ai, bj, At, Bt) do { __builtin_amdgcn_s_setprio(1); _Pragma("unroll") for (int m = 0; m < 4; ++m) _Pragma("unroll") for (int n = 0; n < 2; ++n) _Pragma("unroll") for (int k = 0; k < 2; ++k) \
        acc[ai][bj][m][n] = __builtin_amdgcn_mfma_f32_16x16x32_bf16(Bt[n][k], At[m][k], acc[ai][bj][m][n], 0, 0, 0); __builtin_amdgcn_s_setprio(0); } while (0)
#define PG8_WAIT_V(n) asm volatile("s_waitcnt vmcnt(" #n ")" ::: "memory")
#define PG8_WAIT_L(n) asm volatile("s_waitcnt lgkmcnt(" #n ")" ::: "memory")
#define PG8_BAR __builtin_amdgcn_s_barrier()
#define PG8_SCHED __builtin_amdgcn_sched_barrier(0)
    Unit cur, nxt; int ui = 0;
    if (!S.next(0, cur)) return;
    f32x4 acc[2][2][4][2];
#pragma unroll
    for (int a = 0; a < 2; ++a)
#pragma unroll
        for (int b = 0; b < 2; ++b)
#pragma unroll
            for (int m = 0; m < 4; ++m)
#pragma unroll
                for (int n = 0; n < 2; ++n) acc[a][b][m][n] = (f32x4){0.f, 0.f, 0.f, 0.f};
    bf16x8 At[4][2], B0[2][2], B1[2][2];
    const char* cA = (const char*)g.A + (size_t)cur.pm * tstep; const char* cB = (const char*)g.Bt + (size_t)cur.pn * tstep;
    S.a_ready(cur);
    PG8_STAGE(PG8_SB(0, 0), cB, voffB); PG8_STAGE(PG8_SA(0, 0), cA, voffA); PG8_STAGE(PG8_SB(0, 1), cB + hstep, voffB); PG8_STAGE(PG8_SA(0, 1), cA + hstep, voffA);
    if (wr == 1) PG8_BAR;
    PG8_WAIT_V(4); PG8_BAR;
    PG8_STAGE(PG8_SB(1, 0), cB + kstep, voffB); PG8_STAGE(PG8_SA(1, 0), cA + kstep, voffA); PG8_STAGE(PG8_SB(1, 1), cB + hstep + kstep, voffB);
    PG8_WAIT_V(6); PG8_BAR;
    PG8_STAMP();
    for (;;) {
        const bool has_next = S.next(ui + 1, nxt);
        const char* nA = has_next ? (const char*)g.A + (size_t)nxt.pm * tstep : cA; const char* nB = has_next ? (const char*)g.Bt + (size_t)nxt.pn * tstep : cB;
        for (int t = 0; t < nt; t += 2) {
            const bool last = (t == nt - 2);
            const char* a1 = cA + (size_t)(t + 1) * kstep;
            const char* a2 = last ? nA : cA + (size_t)(t + 2) * kstep; const char* b2 = last ? nB : cB + (size_t)(t + 2) * kstep;
            const char* a3 = a2 + kstep; const char* b3 = b2 + kstep;
            if (last && has_next) S.a_ready(nxt);
            PG8_LDB(B0, 0, 0); PG8_SCHED; PG8_LDA(At, 0, 0); PG8_STAGE(PG8_SA(1, 1), a1 + hstep, voffA);
            PG8_WAIT_L(8); PG8_BAR; PG8_WAIT_L(0); PG8_MMA(0, 0, At, B0); PG8_BAR; PG8_SCHED;
            PG8_LDB(B1, 0, 1); PG8_STAGE(PG8_SB(0, 0), b2, voffB);
            PG8_BAR; PG8_WAIT_L(0); PG8_MMA(0, 1, At, B1); PG8_BAR;
            PG8_LDA(At, 0, 1); PG8_STAGE(PG8_SA(0, 0), a2, voffA);
            PG8_BAR; PG8_WAIT_L(0); PG8_MMA(1, 0, At, B0); PG8_BAR; PG8_SCHED;
            PG8_STAGE(PG8_SB(0, 1), b2 + hstep, voffB);
            PG8_WAIT_V(6); PG8_BAR; PG8_MMA(1, 1, At, B1); PG8_BAR;
            PG8_LDB(B0, 1, 0); PG8_SCHED; PG8_LDA(At, 1, 0); PG8_STAGE(PG8_SA(0, 1), a2 + hstep, voffA);
            PG8_WAIT_L(8); PG8_BAR; PG8_WAIT_L(0); PG8_MMA(0, 0, At, B0); PG8_BAR; PG8_SCHED;
            PG8_LDB(B1, 1, 1); PG8_STAGE(PG8_SB(1, 0), b3, voffB);
            PG8_BAR; PG8_WAIT_L(0); PG8_MMA(0, 1, At, B1); PG8_BAR;
            PG8_LDA(At, 1, 1); PG8_STAGE(PG8_SA(1, 0), a3, voffA);
            PG8_BAR; PG8_WAIT_L(0); PG8_MMA(1, 0, At, B0); PG8_BAR; PG8_SCHED;
            PG8_STAGE(PG8_SB(1, 1), b3 + hstep, voffB);
            PG8_WAIT_V(6); PG8_BAR; PG8_MMA(1, 1, At, B1); PG8_BAR;
        }
        PG8_STAMP();
        if constexpr (!Epi::AFTER_DRAIN) { E(acc, cur, wr, wc, fr, fq); S.done(cur); }
        PG8_STAMP();
        if (!has_next) break;
#pragma unroll
        for (int a = 0; a < 2; ++a)
#pragma unroll
            for (int b = 0; b < 2; ++b)
#pragma unroll
                for (int m = 0; m < 4; ++m)
#pragma unroll
                    for (int n = 0; n < 2; ++n) acc[a][b][m][n] = (f32x4){0.f, 0.f, 0.f, 0.f};
        cur = nxt; cA = nA; cB = nB; ++ui;
    }
    PG8_WAIT_V(0);
    if (wr == 0) PG8_BAR;
    PG8_BAR;
    if constexpr (Epi::AFTER_DRAIN) { E.fused(acc, cur, wr, wc, fr, fq, lds, wid, lane); S.done(cur); }
    PG8_STAMP();
    if (STAMP && wid == 0) { stamps[lane] = lane < nts ? (((unsigned long long)(unsigned)ts_hi << 32) | (unsigned)ts_lo) : 0ull;
        if (lane == 62) stamps[62] = rt_entry; if (lane == 63) stamps[63] = (unsigned long long)wall_clock64(); }
#undef PG8_STAMP
#undef PG8_SA
#undef PG8_SB
#undef PG8_STAGE
#undef PG8_LDA
#undef PG8_LDB
#undef PG8_MMA
#undef PG8_WAIT_V
#undef PG8_WAIT_L
#undef PG8_BAR
#undef PG8_SCHED
}
}

__device__ __forceinline__ int tid_fresh() { int t = threadIdx.x; asm volatile("" : "+v"(t)); return t; }
__device__ __forceinline__ int perm_ab(int p) {
    if (p < 1024) { const int h = p >> 7, q = p & 127; return (h << 7) + (q >> 1) + ((q & 1) << 6); }
    if (p < 2048) return p;
    if (p < 2688) { const int hb = p & ~63, q = p & 63, i = q >> 1; return hb + (i < 16 ? i : 16 + i) + ((q & 1) << 4); }
    return p;
}
__device__ __forceinline__ int perm_up(int p) { const int q = p >> 3, e = p & 7; return e < 4 ? 4 * q + e : DFF + 4 * q + (e - 4); }

struct TrJob { const float* W; bf16_t* Wt; int K, N, ptype, tile; };
__device__ __forceinline__ TrJob tr_job(const Params& p, unsigned char* ws, int t) {
    TrJob j;
    if (t < 704) { j.W = p.ab_w_in; j.K = 1024; j.N = 2816; j.Wt = (bf16_t*)(ws + WS_WABI); j.ptype = 1; j.tile = t; }
    else if (t < 960) { j.W = p.ab_w_out; j.K = 1024; j.N = 1024; j.Wt = (bf16_t*)(ws + WS_WABO); j.ptype = 0; j.tile = t - 704; }
    else if (t < 1728) { j.W = p.na_w_in; j.K = 1024; j.N = 3072; j.Wt = (bf16_t*)(ws + WS_WNAI); j.ptype = 0; j.tile = t - 960; }
    else if (t < 1984) { j.W = p.na_w_out; j.K = 1024; j.N = 1024; j.Wt = (bf16_t*)(ws + WS_WNAO); j.ptype = 0; j.tile = t - 1728; }
    else if (t < 3392) { j.W = p.ffn_w_up; j.K = 1024; j.N = 5632; j.Wt = (bf16_t*)(ws + WS_WUP); j.ptype = 2; j.tile = t - 1984; }
    else if (t < 4800) { j.W = p.ffn_w_up + (size_t)1024 * 5632; j.K = 1024; j.N = 5632; j.Wt = (bf16_t*)(ws + WS_WUP) + (size_t)5632 * 1024; j.ptype = 2; j.tile = t - 3392; }
    else if (t < 5504) { j.W = p.ffn_w_down; j.K = 2816; j.N = 1024; j.Wt = (bf16_t*)(ws + WS_WDN); j.ptype = 0; j.tile = t - 4800; }
    else { j.W = p.ffn_w_down + (size_t)2816 * 1024; j.K = 2816; j.N = 1024; j.Wt = (bf16_t*)(ws + WS_WDN) + (size_t)1024 * 2816; j.ptype = 0; j.tile = t - 5504; }
    return j;
}
__device__ __forceinline__ void tr_load(const TrJob& j, int tid, float (&v)[8]) {
    const int ntn = j.N >> 6;
    const int tk = j.tile / ntn, tn = j.tile - tk * ntn;
    const int jj = tid & 63, i0 = tid >> 6, n = tn * 64 + jj;
    const int ncol = j.ptype == 1 ? perm_ab(n) : (j.ptype == 2 ? perm_up(n) : n);
    const float* src = j.W + (size_t)(tk * 64 + i0) * j.N + ncol;
#pragma unroll
    for (int ii = 0; ii < 8; ++ii) v[ii] = src[(size_t)(8 * ii) * j.N];
}
__device__ __forceinline__ void tr_store(const TrJob& j, int tid, const float (&v)[8], LAS float* T) {
    const int ntn = j.N >> 6;
    const int tk = j.tile / ntn, tn = j.tile - tk * ntn;
    {
        const int jj = tid & 63, i0 = tid >> 6;
#pragma unroll
        for (int ii = 0; ii < 8; ++ii) T[jj * 65 + i0 + 8 * ii] = v[ii];
    }
    __syncthreads();
    {
        const int r = tid >> 3, c = tid & 7;
        LAS float* s = T + r * 65 + c * 8;
        u32x4 w; w.x = cvt_pk_bf16(s[0], s[1]); w.y = cvt_pk_bf16(s[2], s[3]); w.z = cvt_pk_bf16(s[4], s[5]); w.w = cvt_pk_bf16(s[6], s[7]);
        *(u32x4*)(j.Wt + (size_t)(tn * 64 + r) * j.K + tk * 64 + c * 8) = w;
    }
    __syncthreads();
}

__device__ __forceinline__ void prep_phase(const Params& p, LAS unsigned char* lds) {
    unsigned char* ws = p.ws;
    const int tid = tid_fresh(), lane = tid & 63, w = tid >> 6;
    {
        f32x2* rret = (f32x2*)(ws + WS_RRET); f32x2* r2d = (f32x2*)(ws + WS_R2D);
        for (int idx = blockIdx.x * NTHREADS + tid; idx < 2048 * 64 + 64 * 16; idx += gridDim.x * NTHREADS) {
            if (idx < 2048 * 64) { const int t = idx >> 6, i = idx & 63; const float inv = powf(10000.0f, -(float)i / 64.0f); const float ang = (float)t * inv; f32x2 v; v.x = cosf(ang); v.y = sinf(ang); rret[idx] = v; }
            else { const int j = idx - 2048 * 64, pos = j >> 4, i = j & 15; const float inv = powf(10000.0f, -(float)i / 16.0f); const float ang = (float)pos * inv; f32x2 v; v.x = cosf(ang); v.y = sinf(ang); r2d[j] = v; }
        }
    }
    {
        LAS float* sil = (LAS float*)lds;
        float* mod = (float*)(ws + WS_MOD);
        for (int it = (int)gridDim.x - 1 - (int)blockIdx.x; it < 192; it += gridDim.x) {
            __syncthreads();
            for (int idx = tid; idx < 33 * 1024; idx += NTHREADS) { const float v = idx < 32 * 1024 ? p.c[idx] : p.c_ctx[idx - 32 * 1024]; sil[idx] = v / (1.0f + expf(-v)); }
            __syncthreads();
            const int l = it / 96, col0 = (it % 96) * 64;
            const float* wm = p.w_mod + (size_t)l * 1024 * 6144 + col0 + lane;
            float acc[33];
#pragma unroll
            for (int r = 0; r < 33; ++r) acc[r] = 0.f;
            float wn[8];
#pragma unroll
            for (int u = 0; u < 8; ++u) wn[u] = wm[(size_t)(w * 128 + u) * 6144];
            for (int k0 = w * 128; k0 < w * 128 + 128; k0 += 8) {
                float wv[8];
#pragma unroll
                for (int u = 0; u < 8; ++u) wv[u] = wn[u];
                if (k0 + 8 < w * 128 + 128) {
#pragma unroll
                    for (int u = 0; u < 8; ++u) wn[u] = wm[(size_t)(k0 + 8 + u) * 6144];
                }
#pragma unroll
                for (int r = 0; r < 33; ++r) {
                    const f32x4 s0 = *(LAS f32x4*)(sil + r * 1024 + k0), s1 = *(LAS f32x4*)(sil + r * 1024 + k0 + 4);
                    acc[r] += s0[0] * wv[0] + s0[1] * wv[1] + s0[2] * wv[2] + s0[3] * wv[3] + s1[0] * wv[4] + s1[1] * wv[5] + s1[2] * wv[6] + s1[3] * wv[7];
                }
            }
            __syncthreads();
            LAS float* red = (LAS float*)lds;
#pragma unroll
            for (int r = 0; r < 33; ++r) red[(w * 33 + r) * 64 + lane] = acc[r];
            __syncthreads();
            for (int idx = tid; idx < 33 * 64; idx += NTHREADS) {
                const int r = idx >> 6, cc = idx & 63;
                float s = p.b_mod[l * 6144 + col0 + cc];
#pragma unroll
                for (int ww = 0; ww < 8; ++ww) s += red[(ww * 33 + r) * 64 + cc];
                mod[(size_t)(l * 33 + r) * 6144 + col0 + cc] = s;
            }
        }
        __syncthreads();
    }
    {
        LAS float* T = (LAS float*)lds;
        const int G = (int)gridDim.x;
        int t = blockIdx.x;
        if (t < 6208) {
            float curA[8], curB[8], nxtA[8], nxtB[8];
            TrJob jA = tr_job(p, ws, t), jB = jA;
            bool hasB = t + G < 6208;
            tr_load(jA, tid, curA);
            if (hasB) { jB = tr_job(p, ws, t + G); tr_load(jB, tid, curB); }
            for (;;) {
                const int tnA = t + 2 * G, tnB = t + 3 * G;
                const bool nA = tnA < 6208, nB = tnB < 6208;
                TrJob jnA = jA, jnB = jB;
                if (nA) { jnA = tr_job(p, ws, tnA); tr_load(jnA, tid, nxtA); }
                if (nB) { jnB = tr_job(p, ws, tnB); tr_load(jnB, tid, nxtB); }
                tr_store(jA, tid, curA, T);
                if (hasB) tr_store(jB, tid, curB, T);
                if (!nA) break;
#pragma unroll
                for (int i = 0; i < 8; ++i) { curA[i] = nxtA[i]; curB[i] = nxtB[i]; }
                jA = jnA; jB = jnB; hasB = nB; t = tnA;
            }
        }
    }
}

__device__ __forceinline__ void rowwise_phase(const float* xin_lat, const float* xin_ctx, float* xout_lat, float* xout_ctx, const bf16_t* ox,
                                           const float* gpost, const float* modgate, const float* gpre, const float* modshift, const float* modscale, bf16_t* H, int nrows) {
    const int tid = tid_fresh(), lane = tid & 63, gw = blockIdx.x * 8 + (tid >> 6), nw = gridDim.x * 8;
    for (int grp = gw; grp * 4 < nrows; grp += nw) {
        const int rowb = grp * 4;
        const bool lat = rowb < ML; const int mrow = lat ? (rowb >> 11) : 32;
        const float* xi = lat ? xin_lat + (size_t)rowb * 1024 : xin_ctx + (size_t)(rowb - ML) * 1024;
        f32x4 v[4][4]; u32x2 ob[4][4];
#pragma unroll
        for (int u = 0; u < 4; ++u) {
#pragma unroll
            for (int i = 0; i < 4; ++i) v[u][i] = __builtin_nontemporal_load((const f32x4*)(xi + u * 1024 + lane * 4 + 256 * i));
            if (ox) {
#pragma unroll
                for (int i = 0; i < 4; ++i) ob[u][i] = *(const u32x2*)(ox + (size_t)(rowb + u) * 1024 + lane * 4 + 256 * i);
            }
        }
        if (ox) {
            f32x4 gg[4];
            const float* gate = modgate + (size_t)mrow * 6144;
#pragma unroll
            for (int i = 0; i < 4; ++i) { const int col = lane * 4 + 256 * i; gg[i] = *(const f32x4*)(gpost + col) * *(const f32x4*)(gate + col); }
            float* xo = lat ? xout_lat + (size_t)rowb * 1024 : xout_ctx + (size_t)(rowb - ML) * 1024;
#pragma unroll
            for (int u = 0; u < 4; ++u) {
                f32x4 o[4]; float ss = 0.f;
#pragma unroll
                for (int i = 0; i < 4; ++i) {
                    const u32x2 t = ob[u][i];
                    o[i] = (f32x4){bf_lo(t.x), bf_hi(t.x), bf_lo(t.y), bf_hi(t.y)};
                    ss += o[i][0] * o[i][0] + o[i][1] * o[i][1] + o[i][2] * o[i][2] + o[i][3] * o[i][3];
                }
                ss = wave_sum(ss);
                const float rinv = rsqrtf(ss * (1.0f / 1024.0f) + EPSN);
#pragma unroll
                for (int i = 0; i < 4; ++i) {
                    v[u][i] += (o[i] * rinv) * gg[i];
                    __builtin_nontemporal_store(v[u][i], (f32x4*)(xo + u * 1024 + lane * 4 + 256 * i));
                }
            }
        }
        if (H) {
            f32x4 g2[4], s1[4], s0[4];
            const float* sh = modshift + (size_t)mrow * 6144; const float* sc = modscale + (size_t)mrow * 6144;
#pragma unroll
            for (int i = 0; i < 4; ++i) { const int col = lane * 4 + 256 * i; s1[i] = *(const f32x4*)(sc + col) + 1.0f; g2[i] = *(const f32x4*)(gpre + col) * s1[i]; s0[i] = *(const f32x4*)(sh + col); }
#pragma unroll
            for (int u = 0; u < 4; ++u) {
                float ss = 0.f;
#pragma unroll
                for (int i = 0; i < 4; ++i) ss += v[u][i][0] * v[u][i][0] + v[u][i][1] * v[u][i][1] + v[u][i][2] * v[u][i][2] + v[u][i][3] * v[u][i][3];
                ss = wave_sum(ss);
                const float rinv = rsqrtf(ss * (1.0f / 1024.0f) + EPSN);
#pragma unroll
                for (int i = 0; i < 4; ++i) {
                    const f32x4 h = (v[u][i] * rinv) * g2[i] + s0[i];
                    u32x2 wv; wv.x = cvt_pk_bf16(h[0], h[1]); wv.y = cvt_pk_bf16(h[2], h[3]);
                    *(u32x2*)(H + (size_t)(rowb + u) * 1024 + lane * 4 + 256 * i) = wv;
                }
            }
        }
    }
}

__device__ __forceinline__ float silu_f(float x) { return x * __builtin_amdgcn_rcpf(1.0f + __expf(-x)); }
__device__ __forceinline__ void convact_phase(const bf16_t* U, bf16_t* ACT, const float* cw, const float* cb, int row0g, int nrows) {
    const int tid = tid_fresh(), lane = tid & 63, gw = blockIdx.x * 8 + (tid >> 6), nw = gridDim.x * 8;
    const int nitems = (nrows >> 5) * 11;
    for (int it = gw; it < nitems; it += nw) {
        const int slab = it % 11, rb = it / 11;
        const int q = slab * 64 + lane;
        const f32x4 wa0 = *(const f32x4*)(cw + 4 * q), wa1 = *(const f32x4*)(cw + NUP + 4 * q), wa2 = *(const f32x4*)(cw + 2 * NUP + 4 * q), ba = *(const f32x4*)(cb + 4 * q);
        const f32x4 wg0 = *(const f32x4*)(cw + DFF + 4 * q), wg1 = *(const f32x4*)(cw + NUP + DFF + 4 * q), wg2 = *(const f32x4*)(cw + 2 * NUP + DFF + 4 * q), bg = *(const f32x4*)(cb + DFF + 4 * q);
        const int r0 = rb * 32, R0 = row0g + r0;
        const int pos0 = R0 < ML ? (R0 & 2047) : ((R0 - ML) & 255), len = R0 < ML ? 2048 : 256;
        const bf16_t* up = U + (size_t)r0 * NUP + 8 * q;
        const u32x4 zero = (u32x4){0u, 0u, 0u, 0u};
        u32x4 prev = zero, cur;
        if (pos0 > 0) prev = *(const u32x4*)(up - NUP);
        cur = *(const u32x4*)(up);
        for (int g8 = 0; g8 < 4; ++g8) {
            u32x4 nx[8];
#pragma unroll
            for (int j = 0; j < 8; ++j) { const int rr = g8 * 8 + j; nx[j] = zero; if (pos0 + rr + 1 < len) nx[j] = *(const u32x4*)(up + (size_t)(rr + 1) * NUP); }
#pragma unroll
            for (int j = 0; j < 8; ++j) {
                const int rr = g8 * 8 + j;
                const u32x4 nxt = nx[j];
                const f32x4 ap = (f32x4){bf_lo(prev.x), bf_hi(prev.x), bf_lo(prev.y), bf_hi(prev.y)}, gp = (f32x4){bf_lo(prev.z), bf_hi(prev.z), bf_lo(prev.w), bf_hi(prev.w)};
                const f32x4 ac = (f32x4){bf_lo(cur.x), bf_hi(cur.x), bf_lo(cur.y), bf_hi(cur.y)}, gc = (f32x4){bf_lo(cur.z), bf_hi(cur.z), bf_lo(cur.w), bf_hi(cur.w)};
                const f32x4 an = (f32x4){bf_lo(nxt.x), bf_hi(nxt.x), bf_lo(nxt.y), bf_hi(nxt.y)}, gn = (f32x4){bf_lo(nxt.z), bf_hi(nxt.z), bf_lo(nxt.w), bf_hi(nxt.w)};
                const f32x4 a = ba + wa0 * ap + wa1 * ac + wa2 * an;
                const f32x4 g = bg + wg0 * gp + wg1 * gc + wg2 * gn;
                u32x2 wv; wv.x = cvt_pk_bf16(silu_f(g[0]) * a[0], silu_f(g[1]) * a[1]); wv.y = cvt_pk_bf16(silu_f(g[2]) * a[2], silu_f(g[3]) * a[3]);
                *(u32x2*)(ACT + (size_t)(r0 + rr) * DFF + 4 * q) = wv;
                prev = cur; cur = nxt;
            }
        }
    }
}

__device__ __forceinline__ void convfix_phase(const u32x4* HALO, bf16_t* ACT, const float* cw, const float* cb, int nblk) {
    const int tid = tid_fresh();
    const int total = nblk * 2 * 704;
    const u32x4 zero = (u32x4){0u, 0u, 0u, 0u};
    for (int it = blockIdx.x * NTHREADS + tid; it < total; it += gridDim.x * NTHREADS) {
        const int q = it % 704, rr = it / 704, kb = rr >> 1, last = rr & 1;
        const int R = kb * 64 + (last ? 63 : 0);
        const int pos = R < ML ? (R & 2047) : ((R - ML) & 255), len = R < ML ? 2048 : 256;
        u32x4 pv = zero, cv, nv = zero;
        if (!last) { cv = HALO[(size_t)(kb * 4 + 0) * 704 + q]; nv = HALO[(size_t)(kb * 4 + 1) * 704 + q]; if (pos > 0) pv = HALO[(size_t)(kb * 4 - 1) * 704 + q]; }
        else { pv = HALO[(size_t)(kb * 4 + 2) * 704 + q]; cv = HALO[(size_t)(kb * 4 + 3) * 704 + q]; if (pos < len - 1) nv = HALO[(size_t)(kb * 4 + 4) * 704 + q]; }
        const pg8::ConvW w = pg8::load_convw(cw, cb, q);
        *(pg8::u32x2e*)(ACT + (size_t)R * DFF + 4 * q) = pg8::conv_act(w, pv, cv, nv);
    }
}

__device__ __forceinline__ void combine_phase(const bf16_t* Yf, const bf16_t* Yb, const bf16_t* PX, bf16_t* Y) {
    const int tid = tid_fresh(), lane = tid & 63, gw = blockIdx.x * 8 + (tid >> 6), nw = gridDim.x * 8;
    for (int row0 = gw; row0 < MT; row0 += 4 * nw) {
        u32x4 av[4], bv[4], gv[4]; bool ok[4];
#pragma unroll
        for (int u = 0; u < 4; ++u) {
            const int row = row0 + u * nw; ok[u] = row < MT;
            const int rr = ok[u] ? row : row0;
            av[u] = *(const u32x4*)(Yf + (size_t)rr * 512 + lane * 8); bv[u] = *(const u32x4*)(Yb + (size_t)rr * 512 + lane * 8);
            gv[u] = *(const u32x4*)(PX + (size_t)rr * ABIN + 1536 + lane * 8);
        }
#pragma unroll
        for (int u = 0; u < 4; ++u) {
            if (!ok[u]) continue;
            const int row = row0 + u * nw;
            const u32x4 a = av[u], b = bv[u], g = gv[u];
            float y[8], gg[8];
            y[0] = bf_lo(a.x) + bf_lo(b.x); y[1] = bf_hi(a.x) + bf_hi(b.x); y[2] = bf_lo(a.y) + bf_lo(b.y); y[3] = bf_hi(a.y) + bf_hi(b.y);
            y[4] = bf_lo(a.z) + bf_lo(b.z); y[5] = bf_hi(a.z) + bf_hi(b.z); y[6] = bf_lo(a.w) + bf_lo(b.w); y[7] = bf_hi(a.w) + bf_hi(b.w);
            gg[0] = bf_lo(g.x); gg[1] = bf_hi(g.x); gg[2] = bf_lo(g.y); gg[3] = bf_hi(g.y); gg[4] = bf_lo(g.z); gg[5] = bf_hi(g.z); gg[6] = bf_lo(g.w); gg[7] = bf_hi(g.w);
            float ss = 0.f;
#pragma unroll
            for (int i = 0; i < 8; ++i) ss += y[i] * y[i];
            ss += __shfl_xor(ss, 1); ss += __shfl_xor(ss, 2); ss += __shfl_xor(ss, 4); ss += __shfl_xor(ss, 8);
            const float rinv = rsqrtf(ss * (1.0f / 128.0f) + EPSN);
            float o[8];
#pragma unroll
            for (int i = 0; i < 8; ++i) o[i] = y[i] * rinv * silu_f(gg[i]);
            u32x4 wv; wv.x = cvt_pk_bf16(o[0], o[1]); wv.y = cvt_pk_bf16(o[2], o[3]); wv.z = cvt_pk_bf16(o[4], o[5]); wv.w = cvt_pk_bf16(o[6], o[7]);
            *(u32x4*)(Y + (size_t)row * 1024 + lane * 8) = wv;
        }
    }
}

__device__ __forceinline__ u32x4 scale8(u32x4 v, float s) {
    u32x4 r;
    r.x = cvt_pk_bf16v(bf_lo(v.x) * s, bf_hi(v.x) * s); r.y = cvt_pk_bf16v(bf_lo(v.y) * s, bf_hi(v.y) * s);
    r.z = cvt_pk_bf16v(bf_lo(v.z) * s, bf_hi(v.z) * s); r.w = cvt_pk_bf16v(bf_lo(v.w) * s, bf_hi(v.w) * s);
    return r;
}
__device__ __forceinline__ void retention_phase(const Params& p, LAS unsigned char* lds, const bf16_t* PX, bf16_t* Yf, bf16_t* Yb) {
    const int tid = tid_fresh(), lane = tid & 63, w = __builtin_amdgcn_readfirstlane(tid >> 6), l15 = lane & 15, quad = lane >> 4, qq = l15 >> 2, pp = lane & 3;
    LAS unsigned char* Qs = lds; LAS unsigned char* Ks = lds + 32768; LAS unsigned char* Vs = lds + 65536; LAS unsigned char* As = lds + 98304;
    const unsigned fl = (((unsigned)l15 & 3u) << 2) | (((unsigned)l15 >> 2) & 3u);
    unsigned ra[4], q2a[4], q2b[4], awb, tv1, tv2, tk1b, tk2b;
#pragma unroll
    for (int ks = 0; ks < 4; ++ks) {
        ra[ks] = 256u * l15 + 16u * (((unsigned)(4 * ks + quad)) ^ fl);
        q2a[ks] = 256u * l15 + 16u * (((unsigned)(4 * ks + (quad >> 1))) ^ fl) + 8u * (quad & 1);
        q2b[ks] = 256u * l15 + 16u * (((unsigned)(4 * ks + 2 + (quad >> 1))) ^ fl) + 8u * (quad & 1);
    }
    awb = 256u * (16 * w + l15) + 16u * (((unsigned)(quad >> 1)) ^ fl) + 8u * (quad & 1);
    {
        const unsigned r1 = (unsigned)(8 * quad + qq), r2 = r1 + 4u;
        const unsigned f1 = ((r1 & 3u) << 2) | ((r1 >> 2) & 3u), f2 = ((r2 & 3u) << 2) | ((r2 >> 2) & 3u);
        tv1 = 256u * r1 + 16u * (((unsigned)(2 * w + (pp >> 1))) ^ f1) + 8u * (pp & 1);
        tv2 = 256u * r2 + 16u * (((unsigned)(2 * w + (pp >> 1))) ^ f2) + 8u * (pp & 1);
        tk1b = 256u * r1 + 16u * (((unsigned)(pp >> 1)) ^ f1) + 8u * (pp & 1); tk2b = 256u * r2 + 16u * (((unsigned)(pp >> 1)) ^ f2) + 8u * (pp & 1);
    }
    for (int item = blockIdx.x; item < 256; item += gridDim.x) {
        const int dir = item & 1, h = (item >> 1) & 3, b = item >> 3;
        const float de = p.ret_decay[dir * 4 + h];
        const float lg2 = log1pf(-exp2f(-de)) * 1.4426950408889634f;
        const float cdec = exp2f(lg2 * 128.0f);
        f32x4 S[8];
#pragma unroll
        for (int i = 0; i < 8; ++i) S[i] = (f32x4){0.f, 0.f, 0.f, 0.f};
        bf16_t* Yo = dir ? Yb : Yf;
#define RET_C0(S) ((S) < 2 ? ML + b * 256 + (dir ? 1 - (S) : (S)) * 128 : b * 2048 + (dir ? 17 - (S) : (S) - 2) * 128)
#define RET_LOAD(S) do { const int c0n_ = RET_C0(S); _Pragma("unroll") for (int c = 0; c < 4; ++c) { const int idx = tid + 512 * c, i = idx >> 4, ch = idx & 15; \
            const int tok = dir ? c0n_ + 127 - i : c0n_ + i; const bf16_t* src = PX + (size_t)tok * ABIN + h * 128 + ch * 8; \
            qn[c] = *(const u32x4*)(src); kn[c] = *(const u32x4*)(src + 512); vn[c] = *(const u32x4*)(src + 1024); } } while (0)
        u32x4 qn[4], kn[4], vn[4];
        RET_LOAD(0);
        for (int s = 0; s < 18; ++s) {
            const int c0 = RET_C0(s);
            __syncthreads();
#pragma unroll
            for (int c = 0; c < 4; ++c) {
                const int idx = tid + 512 * c, i = idx >> 4, ch = idx & 15;
                const unsigned o = off256(i, ch);
                *(LAS u32x4*)(Qs + o) = qn[c]; *(LAS u32x4*)(Vs + o) = vn[c];
                *(LAS u32x4*)(Ks + o) = scale8(kn[c], __builtin_amdgcn_exp2f(lg2 * (float)(127 - i)));
            }
            __syncthreads();
            if (s + 1 < 18) { RET_LOAD(s + 1); }
            {
                bf16x8 qf[4];
#pragma unroll
                for (int ks = 0; ks < 4; ++ks) qf[ks] = *(LAS bf16x8*)(Qs + ra[ks] + 4096u * w);
                const int i = 16 * w + l15;
                const float rowsc = __builtin_amdgcn_exp2f(lg2 * (float)(i - 127));
#pragma unroll
                for (int nt = 0; nt < 8; ++nt) {
                    f32x4 at = (f32x4){0.f, 0.f, 0.f, 0.f};
                    if (nt <= w) {
#pragma unroll
                        for (int ks = 0; ks < 4; ++ks) { const bf16x8 kf = *(LAS bf16x8*)(Ks + ra[ks] + 4096u * nt); at = MFMA16(kf, qf[ks], at); }
#pragma unroll
                        for (int jj = 0; jj < 4; ++jj) { const int diff = i - (16 * nt + 4 * quad + jj); const bool keep = dir ? (diff > 0) : (diff >= 0); at[jj] = keep ? at[jj] * rowsc : 0.f; }
                    }
                    u32x2 wv; wv.x = cvt_pk_bf16v(at[0], at[1]); wv.y = cvt_pk_bf16v(at[2], at[3]);
                    *(LAS u32x2*)(As + (awb ^ (32u * nt))) = wv;
                }
            }
            __syncthreads();
            bf16x8 vf[4], sf[4];
#pragma unroll
            for (int ks = 0; ks < 4; ++ks) {
                vf[ks] = cat4(tr_read(Vs + tv1 + 8192u * ks), tr_read(Vs + tv2 + 8192u * ks));
                sf[ks] = pack8v(S[2 * ks], S[2 * ks + 1]);
            }
#pragma unroll
            for (int it = 0; it < 8; ++it) {
                f32x4 o2 = (f32x4){0.f, 0.f, 0.f, 0.f};
#pragma unroll
                for (int pk = 0; pk < 4; ++pk) {
                    const s16x4 qa = *(LAS s16x4*)(Qs + q2a[pk] + 4096u * it);
                    const s16x4 qb = *(LAS s16x4*)(Qs + q2b[pk] + 4096u * it);
                    o2 = MFMA16(sf[pk], cat4(qa, qb), o2);
                }
                f32x4 o1 = (f32x4){0.f, 0.f, 0.f, 0.f};
#pragma unroll
                for (int ks = 0; ks < 4; ++ks) if (ks <= (it >> 1)) { const bf16x8 af = *(LAS bf16x8*)(As + ra[ks] + 4096u * it); o1 = MFMA16(vf[ks], af, o1); }
                const int i = 16 * it + l15;
                const float qd = __builtin_amdgcn_exp2f(lg2 * (float)(i + 1));
                const int tok = dir ? c0 + 127 - i : c0 + i;
                u32x2 wv; wv.x = cvt_pk_bf16v(o1[0] + qd * o2[0], o1[1] + qd * o2[1]); wv.y = cvt_pk_bf16v(o1[2] + qd * o2[2], o1[3] + qd * o2[3]);
                *(u32x2*)(Yo + (size_t)tok * 512 + h * 128 + 16 * w + 4 * quad) = wv;
            }
#pragma unroll
            for (int dt = 0; dt < 8; ++dt) {
                f32x4 acc = S[dt] * cdec;
#pragma unroll
                for (int ks = 0; ks < 4; ++ks) {
                    const bf16x8 kf = cat4(tr_read(Ks + (tk1b ^ (32u * dt)) + 8192u * ks), tr_read(Ks + (tk2b ^ (32u * dt)) + 8192u * ks));
                    acc = MFMA16(kf, vf[ks], acc);
                }
                S[dt] = acc;
            }
        }
    }
    __syncthreads();
#undef RET_C0
#undef RET_LOAD
}

__device__ __forceinline__ void swa_phase(const Params& p, LAS unsigned char* lds, const bf16_t* PX, bf16_t* Y) {
    const int tid = tid_fresh(), lane = tid & 63, w = __builtin_amdgcn_readfirstlane(tid >> 6), l15 = lane & 15, quad = lane >> 4, qq = l15 >> 2, pp = lane & 3;
    LAS unsigned char* Ks = lds; LAS unsigned char* Vs = lds + 16384;
    unsigned ka[2], va[4];
#pragma unroll
    for (int ks = 0; ks < 2; ++ks) ka[ks] = 128u * l15 + 16u * (((unsigned)(4 * ks + quad)) ^ ((unsigned)l15 & 7u));
#pragma unroll
    for (int vt = 0; vt < 4; ++vt) va[vt] = 128u * (4 * quad + qq) + 16u * (((unsigned)(2 * vt + (pp >> 1))) ^ ((unsigned)(4 * quad + qq) & 7u)) + 8u * (pp & 1);
#define SWA_MASK(IT) ((IT) >= 1024 ? 0x18u : (0x1Au | (((IT) & 15) > 0 ? 1u : 0u) | (((IT) & 15) < 15 ? 4u : 0u)))
#define SWA_PREF(IT, C) do { int b_, kvh_, qb_; if ((IT) < 1024) { qb_ = (IT) & 15; kvh_ = ((IT) >> 4) & 1; b_ = (IT) >> 5; } else { const int t_ = (IT) - 1024; qb_ = t_ & 1; kvh_ = (t_ >> 1) & 1; b_ = t_ >> 2; } \
        const size_t kr_ = (C) < 3 ? (size_t)b_ * 2048 + (qb_ - 1 + (C)) * 128 : (size_t)ML + b_ * 256 + ((C) - 3) * 128; \
        _Pragma("unroll") for (int cc = 0; cc < 2; ++cc) { const int idx = tid + 512 * cc, j = idx >> 3, ch = idx & 7; const bf16_t* src = PX + (kr_ + j) * ABIN + 2560 + kvh_ * 64 + ch * 8; \
            kreg[cc] = *(const u32x4*)(src); vreg[cc] = *(const u32x4*)(src + 128); } } while (0)
    int item = blockIdx.x;
    if (item < 1152) {
    u32x4 kreg[2], vreg[2];
    unsigned msk = SWA_MASK(item);
    int c = __builtin_ctz(msk);
    SWA_PREF(item, c);
    for (;;) {
        const bool isctx = item >= 1024;
        int b, kvh, qb;
        if (!isctx) { qb = item & 15; kvh = (item >> 4) & 1; b = item >> 5; } else { const int t = item - 1024; qb = t & 1; kvh = (t >> 1) & 1; b = t >> 2; }
        const int qh = kvh * 4 + (w >> 1);
        const int qpos0 = qb * 128 + 64 * (w & 1);
        const size_t qrow0 = isctx ? (size_t)ML + b * 256 + qpos0 : (size_t)b * 2048 + qpos0;
        bf16x8 qf[4][2];
#pragma unroll
        for (int it = 0; it < 4; ++it)
#pragma unroll
            for (int ks = 0; ks < 2; ++ks) qf[it][ks] = *(const bf16x8*)(PX + (qrow0 + 16 * it + l15) * ABIN + 2048 + qh * 64 + 32 * ks + 8 * quad);
        const float sink = p.swa_sink[qh] * 1.4426950408889634f;
        float mrun[4], lrun[4]; f32x4 o[4][4];
#pragma unroll
        for (int it = 0; it < 4; ++it) { mrun[it] = sink; lrun[it] = 0.f;
#pragma unroll
            for (int vt = 0; vt < 4; ++vt) o[vt][it] = (f32x4){0.f, 0.f, 0.f, 0.f}; }
        const int nxt_item = item + (int)gridDim.x;
        for (;;) {
            const bool local = c < 3;
            const int kstart = (qb - 1 + c) * 128;
            __syncthreads();
#pragma unroll
            for (int cc = 0; cc < 2; ++cc) { const int idx = tid + 512 * cc, j = idx >> 3, ch = idx & 7; *(LAS u32x4*)(Ks + off128(j, ch)) = kreg[cc]; *(LAS u32x4*)(Vs + off128(j, ch)) = vreg[cc]; }
            __syncthreads();
            const unsigned rest = msk & ~((2u << c) - 1u);
            int nc = 0;
            if (rest) { nc = __builtin_ctz(rest); SWA_PREF(item, nc); }
            else if (nxt_item < 1152) { nc = __builtin_ctz(SWA_MASK(nxt_item)); SWA_PREF(nxt_item, nc); }
            for (int kk = 0; kk < 4; ++kk) {
                const int g0 = kstart + 32 * kk;
                if (local && (g0 + 31 < qpos0 - 128 || g0 > qpos0 + 63 + 128)) continue;
                const bool needmask = local && !(g0 >= qpos0 - 65 && g0 + 31 <= qpos0 + 128);
                f32x4 st[4][2];
#pragma unroll
                for (int it = 0; it < 4; ++it) { st[it][0] = (f32x4){0.f, 0.f, 0.f, 0.f}; st[it][1] = (f32x4){0.f, 0.f, 0.f, 0.f}; }
#pragma unroll
                for (int jt = 0; jt < 2; ++jt)
#pragma unroll
                    for (int ks = 0; ks < 2; ++ks) {
                        const bf16x8 kf = *(LAS bf16x8*)(Ks + ka[ks] + 128u * (32 * kk + 16 * jt));
#pragma unroll
                        for (int it = 0; it < 4; ++it) st[it][jt] = MFMA16(kf, qf[it][ks], st[it][jt]);
                    }
                bf16x8 pf[4];
#pragma unroll
                for (int it = 0; it < 4; ++it) {
                    float mx = -1e30f;
                    if (needmask) {
                        const int qpos = qpos0 + 16 * it + l15;
#pragma unroll
                        for (int jt = 0; jt < 2; ++jt)
#pragma unroll
                            for (int jj = 0; jj < 4; ++jj) { const int d = qpos - (g0 + 16 * jt + 4 * quad + jj); if (d > 128 || d < -128) st[it][jt][jj] = -1e30f; }
                    }
#pragma unroll
                    for (int jt = 0; jt < 2; ++jt)
#pragma unroll
                        for (int jj = 0; jj < 4; ++jj) mx = fmaxf(mx, st[it][jt][jj]);
                    mx = fmaxf(mx, __shfl_xor(mx, 16)); mx = fmaxf(mx, __shfl_xor(mx, 32));
                    const float mnew = fmaxf(mrun[it], mx);
                    const float sc = __builtin_amdgcn_exp2f(mrun[it] - mnew);
                    float ps = 0.f;
#pragma unroll
                    for (int jt = 0; jt < 2; ++jt)
#pragma unroll
                        for (int jj = 0; jj < 4; ++jj) { const float e = __builtin_amdgcn_exp2f(st[it][jt][jj] - mnew); st[it][jt][jj] = e; ps += e; }
                    lrun[it] = lrun[it] * sc + ps; mrun[it] = mnew;
                    if (__builtin_amdgcn_ballot_w64(sc < 1.0f) != 0ull) {
#pragma unroll
                        for (int vt = 0; vt < 4; ++vt) o[vt][it] *= sc;
                    }
                    pf[it] = pack8(st[it][0], st[it][1]);
                }
#pragma unroll
                for (int vt = 0; vt < 4; ++vt) {
                    const bf16x8 vf = cat4(tr_read(Vs + va[vt] + 128u * (32 * kk)), tr_read(Vs + va[vt] + 128u * (32 * kk + 16)));
#pragma unroll
                    for (int it = 0; it < 4; ++it) o[vt][it] = MFMA16(vf, pf[it], o[vt][it]);
                }
            }
            if (!rest) { c = nc; break; }
            c = nc;
        }
#pragma unroll
        for (int it = 0; it < 4; ++it) {
            float lt = lrun[it]; lt += __shfl_xor(lt, 16); lt += __shfl_xor(lt, 32);
            lt += __builtin_amdgcn_exp2f(sink - mrun[it]);
            const float inv = 1.0f / lt;
            bf16_t* dst = Y + (qrow0 + 16 * it + l15) * 1024 + 512 + qh * 64 + 4 * quad;
#pragma unroll
            for (int vt = 0; vt < 4; ++vt) { u32x2 wv; wv.x = cvt_pk_bf16(o[vt][it][0] * inv, o[vt][it][1] * inv); wv.y = cvt_pk_bf16(o[vt][it][2] * inv, o[vt][it][3] * inv); *(u32x2*)(dst + 16 * vt) = wv; }
        }
        item = nxt_item;
        if (item >= 1152) break;
        msk = SWA_MASK(item);
    }
    }
#undef SWA_MASK
#undef SWA_PREF
    __syncthreads();
}

__device__ __forceinline__ void na_phase(const Params& p, LAS unsigned char* lds, const bf16_t* QKV, bf16_t* Y) {
    const int tid = tid_fresh(), lane = tid & 63, w = __builtin_amdgcn_readfirstlane(tid >> 6), l15 = lane & 15, quad = lane >> 4, qq = l15 >> 2, pp = lane & 3;
    LAS unsigned char* Ks = lds; LAS unsigned char* Vs = lds + 32768; LAS float* rp = (LAS float*)(lds + 65536);
    const int hh = w >> 2, m = w & 3;
    const int pq = ((quad & 1) << 1) | (quad >> 1);
    const int kl = (((((l15 >> 2) & 1) << 1) | (l15 >> 3)) << 2) | (l15 & 3);
    const int sup0 = min(max(16 * m - 8, 0), 32);
    const int qc = 16 * m + l15, qstart = min(max(qc - 8, 0), 48);
    unsigned kaL[2], kaC[2], vaL[4], vaC[4];
    {
        const unsigned rl = (unsigned)(sup0 + kl), fL = ((rl & 3u) << 2) | ((rl >> 2) & 3u), rc = (unsigned)kl, fC = ((rc & 3u) << 2) | ((rc >> 2) & 3u);
#pragma unroll
        for (int ks = 0; ks < 2; ++ks) { kaL[ks] = 256u * rl + 16u * (((unsigned)(8 * hh + 4 * ks + quad)) ^ fL); kaC[ks] = 256u * rc + 16u * (((unsigned)(8 * hh + 4 * ks + quad)) ^ fC); }
        const unsigned r1l = (unsigned)(sup0 + 4 * pq + qq), f1L = ((r1l & 3u) << 2) | ((r1l >> 2) & 3u), r1c = (unsigned)(4 * pq + qq), f1C = ((r1c & 3u) << 2) | ((r1c >> 2) & 3u);
#pragma unroll
        for (int vt = 0; vt < 4; ++vt) { vaL[vt] = 256u * r1l + 16u * (((unsigned)(8 * hh + 2 * vt + (pp >> 1))) ^ f1L) + 8u * (pp & 1); vaC[vt] = 256u * r1c + 16u * (((unsigned)(8 * hh + 2 * vt + (pp >> 1))) ^ f1C) + 8u * (pp & 1); }
    }
    int bofs[2][4];
#pragma unroll
    for (int jt = 0; jt < 2; ++jt)
#pragma unroll
        for (int jj = 0; jj < 4; ++jj) {
            const int kc = sup0 + 16 * jt + 4 * pq + jj;
            const bool valid = (kc >= qstart) && (kc < qstart + 16);
            bofs[jt][jj] = 4 * (hh * 480 + (valid ? (kc - qc + 15) : 31));
        }
    bool hi[4]; int bsel[4];
#pragma unroll
    for (int jj = 0; jj < 4; ++jj) {
        const int kc0 = sup0 + 4 * pq + jj;
        hi[jj] = !((kc0 >= qstart) && (kc0 < qstart + 16));
        bsel[jj] = 4 * (hh * 480 + ((hi[jj] ? kc0 + 16 : kc0) - qc + 15));
    }
    const int nitems = 8192;
    int item = blockIdx.x;
    if (item < nitems) {
        u32x4 kreg[4], vreg[4]; bf16x8 qnext[2];
        int cur_hp = -1;
#define NA_PREF(IT, C) do { const int hp_ = (IT) & 7, r_ = ((IT) >> 3) & 31, b_ = (IT) >> 8; const int rs_ = min(max(r_ - 4, 0), 24); \
        _Pragma("unroll") for (int cc = 0; cc < 4; ++cc) { const int idx = tid + 512 * cc, j = idx >> 4, ch = idx & 15; \
            const size_t tok = (C) < 4 ? (size_t)b_ * 2048 + (rs_ + 2 * (C) + (j >> 6)) * 64 + (j & 63) : (size_t)ML + b_ * 256 + ((C) - 4) * 128 + j; \
            const bf16_t* src = QKV + tok * NA3 + 1024 + hp_ * 128 + ch * 8; kreg[cc] = *(const u32x4*)(src); vreg[cc] = *(const u32x4*)(src + 1024); } } while (0)
#define NA_PREFQ(IT) do { const int hp_ = (IT) & 7, r_ = ((IT) >> 3) & 31, b_ = (IT) >> 8; const size_t qt_ = (size_t)b_ * 2048 + r_ * 64 + 16 * m + l15; \
        _Pragma("unroll") for (int ks = 0; ks < 2; ++ks) qnext[ks] = *(const bf16x8*)(QKV + qt_ * NA3 + (2 * hp_ + hh) * 64 + 32 * ks + 8 * quad); } while (0)
#define NA_STAGE(C) do { __syncthreads(); \
        if ((C) == 0 && hp != cur_hp) { for (int idx = tid; idx < 960; idx += NTHREADS) { const int hq = idx / 480, rem = idx - hq * 480, dr = rem >> 5, dc = rem & 31; rp[idx] = dc < 31 ? p.na_rpb[(2 * hp + hq) * 465 + dr * 31 + dc] * 1.4426950408889634f : -1e30f; } cur_hp = hp; } \
        _Pragma("unroll") for (int cc = 0; cc < 4; ++cc) { const int idx = tid + 512 * cc, j = idx >> 4, ch = idx & 15; *(LAS u32x4*)(Ks + off256(j, ch)) = kreg[cc]; *(LAS u32x4*)(Vs + off256(j, ch)) = vreg[cc]; } \
        __syncthreads(); } while (0)
#define NA_SOFTMAX_PV(VA, VOFF0, VOFF1) do { \
        float mx = -1e30f; \
        _Pragma("unroll") for (int gi = 0; gi < 2; ++gi) _Pragma("unroll") for (int jt = 0; jt < 2; ++jt) _Pragma("unroll") for (int jj = 0; jj < 4; ++jj) mx = fmaxf(mx, s[gi][jt][jj]); \
        mx = fmaxf(mx, __shfl_xor(mx, 16)); mx = fmaxf(mx, __shfl_xor(mx, 32)); \
        const float mnew = fmaxf(mrun, mx); const float sc = __builtin_amdgcn_exp2f(mrun - mnew); float ps = 0.f; \
        _Pragma("unroll") for (int gi = 0; gi < 2; ++gi) _Pragma("unroll") for (int jt = 0; jt < 2; ++jt) _Pragma("unroll") for (int jj = 0; jj < 4; ++jj) { const float e = __builtin_amdgcn_exp2f(s[gi][jt][jj] - mnew); s[gi][jt][jj] = e; ps += e; } \
        lrun = lrun * sc + ps; mrun = mnew; \
        _Pragma("unroll") for (int vt = 0; vt < 4; ++vt) o[vt] *= sc; \
        _Pragma("unroll") for (int gi = 0; gi < 2; ++gi) { const bf16x8 pf = pack8(s[gi][0], s[gi][1]); const unsigned vo = gi ? (VOFF1) : (VOFF0); \
            _Pragma("unroll") for (int vt = 0; vt < 4; ++vt) { const bf16x8 vf = cat4(tr_read(Vs + VA[vt] + vo), tr_read(Vs + VA[vt] + vo + 4096u)); o[vt] = MFMA16(vf, pf, o[vt]); } } } while (0)
        NA_PREF(item, 0); NA_PREFQ(item);
        for (;;) {
            const int hp = item & 7, r = (item >> 3) & 31, b = item >> 8;
            const int h = 2 * hp + hh;
            const int rs = min(max(r - 4, 0), 24);
            const size_t qtok = (size_t)b * 2048 + r * 64 + 16 * m + l15;
            bf16x8 qf[2]; qf[0] = qnext[0]; qf[1] = qnext[1];
            float mrun = -1e30f, lrun = 0.f; f32x4 o[4];
#pragma unroll
            for (int vt = 0; vt < 4; ++vt) o[vt] = (f32x4){0.f, 0.f, 0.f, 0.f};
            const int nxt_item = item + (int)gridDim.x;
            for (int c = 0; c < 4; ++c) {
                NA_STAGE(c);
                NA_PREF(item, c + 1);
                f32x4 s[2][2];
#pragma unroll
                for (int gi = 0; gi < 2; ++gi)
#pragma unroll
                    for (int jt = 0; jt < 2; ++jt) {
                        s[gi][jt] = (f32x4){0.f, 0.f, 0.f, 0.f};
#pragma unroll
                        for (int ks = 0; ks < 2; ++ks) { const bf16x8 kf = *(LAS bf16x8*)(Ks + kaL[ks] + 256u * (64 * gi + 16 * jt)); s[gi][jt] = MFMA16(kf, qf[ks], s[gi][jt]); }
                    }
                {
                    f32x4 t[2];
#pragma unroll
                    for (int gi = 0; gi < 2; ++gi) {
                        const int rowoff = 4 * ((rs + 2 * c + gi - r + 7) * 32);
#pragma unroll
                        for (int jj = 0; jj < 4; ++jj) t[gi][jj] = (hi[jj] ? s[gi][1][jj] : s[gi][0][jj]) + *(LAS float*)((LAS unsigned char*)rp + (bsel[jj] + rowoff));
                    }
                    float mx = fmaxf(fmaxf(fmaxf(t[0][0], t[0][1]), fmaxf(t[0][2], t[0][3])), fmaxf(fmaxf(t[1][0], t[1][1]), fmaxf(t[1][2], t[1][3])));
                    mx = fmaxf(mx, __shfl_xor(mx, 16)); mx = fmaxf(mx, __shfl_xor(mx, 32));
                    const float mnew = fmaxf(mrun, mx); const float sc = __builtin_amdgcn_exp2f(mrun - mnew); float ps = 0.f;
#pragma unroll
                    for (int gi = 0; gi < 2; ++gi)
#pragma unroll
                        for (int jj = 0; jj < 4; ++jj) { const float e = __builtin_amdgcn_exp2f(t[gi][jj] - mnew); ps += e; s[gi][0][jj] = hi[jj] ? 0.f : e; s[gi][1][jj] = hi[jj] ? e : 0.f; }
                    lrun = lrun * sc + ps; mrun = mnew;
#pragma unroll
                    for (int vt = 0; vt < 4; ++vt) o[vt] *= sc;
#pragma unroll
                    for (int gi = 0; gi < 2; ++gi) {
                        const bf16x8 pf = pack8(s[gi][0], s[gi][1]); const unsigned vo = gi ? 16384u : 0u;
#pragma unroll
                        for (int vt = 0; vt < 4; ++vt) { const bf16x8 vf = cat4(tr_read(Vs + vaL[vt] + vo), tr_read(Vs + vaL[vt] + vo + 4096u)); o[vt] = MFMA16(vf, pf, o[vt]); }
                    }
                }
            }
            for (int c = 4; c < 6; ++c) {
                NA_STAGE(c);
                if (c < 5) { NA_PREF(item, c + 1); }
                else if (nxt_item < nitems) { NA_PREF(nxt_item, 0); NA_PREFQ(nxt_item); }
#pragma unroll
                for (int st = 0; st < 2; ++st) {
                    f32x4 s[2][2];
#pragma unroll
                    for (int gi = 0; gi < 2; ++gi)
#pragma unroll
                        for (int jt = 0; jt < 2; ++jt) {
                            s[gi][jt] = (f32x4){0.f, 0.f, 0.f, 0.f};
#pragma unroll
                            for (int ks = 0; ks < 2; ++ks) { const bf16x8 kf = *(LAS bf16x8*)(Ks + kaC[ks] + 256u * (64 * st + 32 * gi + 16 * jt)); s[gi][jt] = MFMA16(kf, qf[ks], s[gi][jt]); }
                        }
                    NA_SOFTMAX_PV(vaC, 256u * (64 * st), 256u * (64 * st + 32));
                }
            }
            float lt = lrun; lt += __shfl_xor(lt, 16); lt += __shfl_xor(lt, 32);
            const float inv = 1.0f / lt;
            bf16_t* dst = Y + qtok * 1024 + h * 64 + 4 * quad;
#pragma unroll
            for (int vt = 0; vt < 4; ++vt) { u32x2 wv; wv.x = cvt_pk_bf16(o[vt][0] * inv, o[vt][1] * inv); wv.y = cvt_pk_bf16(o[vt][2] * inv, o[vt][3] * inv); *(u32x2*)(dst + 16 * vt) = wv; }
            item = nxt_item;
            if (item >= nitems) break;
        }
#undef NA_PREF
#undef NA_PREFQ
#undef NA_STAGE
#undef NA_SOFTMAX_PV
    }
    __syncthreads();
}


__device__ __forceinline__ void run_gemm(LAS unsigned char* lds, const bf16_t* A, const bf16_t* Bt, int M, int N, int K, bf16_t* O, int ldc, int mode, const unsigned char* ws) {
    pg8::Gemm g{A, Bt, M, N, K};
    pg8::StaticOrder S; S.init(M, N, (int)gridDim.x, (int)blockIdx.x);
    pg8::EpiOut E{O, ldc, mode, (const f32x4*)(ws + WS_RRET), (const f32x4*)(ws + WS_R2D)};
    pg8::gemm_phase<pg8::EpiOut, pg8::StaticOrder, false>(lds, g, S, E, nullptr);
}
__device__ __forceinline__ void run_gemm_conv(LAS unsigned char* lds, const bf16_t* A, const bf16_t* Bt, int M, bf16_t* ACT, u32x4* HALO, const float* cw, const float* cb) {
    pg8::Gemm g{A, Bt, M, NUP, 1024};
    pg8::StaticOrder S; S.init(M, NUP, (int)gridDim.x, (int)blockIdx.x);
    pg8::EpiConv E{ACT, (pg8::u32x4*)HALO, cw, cb};
    pg8::gemm_phase<pg8::EpiConv, pg8::StaticOrder, false>(lds, g, S, E, nullptr);
}

__global__ void __launch_bounds__(NTHREADS, 2) hybrid_fwd_megakernel(Params p) {
    extern __shared__ __attribute__((aligned(16))) unsigned char lds_raw[];
    LAS unsigned char* lds = (LAS unsigned char*)lds_raw;
    cg::grid_group grid = cg::this_grid();
    unsigned char* ws = p.ws;
    bf16_t* H = (bf16_t*)(ws + WS_H); bf16_t* PX = (bf16_t*)(ws + WS_PX); bf16_t* Y = (bf16_t*)(ws + WS_Y); bf16_t* OX = (bf16_t*)(ws + WS_OX);
    bf16_t* ACT = PX; u32x4* HALO = (u32x4*)(ws + WS_HALO); bf16_t* Yf = OX; bf16_t* Yb = OX + (size_t)MT * 512;
    float* CTXR = (float*)(ws + WS_CTX);
    const float* mod0 = (const float*)(ws + WS_MOD); const float* mod1 = mod0 + 33 * 6144;
    const bf16_t* WABI = (const bf16_t*)(ws + WS_WABI); const bf16_t* WABO = (const bf16_t*)(ws + WS_WABO);
    const bf16_t* WNAI = (const bf16_t*)(ws + WS_WNAI); const bf16_t* WNAO = (const bf16_t*)(ws + WS_WNAO);
    const bf16_t* WUP = (const bf16_t*)(ws + WS_WUP); const bf16_t* WDN = (const bf16_t*)(ws + WS_WDN);
    const float* ng0 = p.norm_g; const float* ng1 = p.norm_g + 4096;

    volatile LAS unsigned* xst = (volatile LAS unsigned*)(lds + LDS_BYTES - 16);
    if (threadIdx.x < 4) xst[threadIdx.x] = 0u;
    __syncthreads();
    const XcdBarrier xbar = xcd_barrier_post((unsigned*)(ws + WS_BAR), xst);
#define GSYNC() xcd_barrier(xbar)
#ifdef PROBE_GROUP
    unsigned long long pr_acc = 0, pr_t0 = __builtin_amdgcn_s_memrealtime();
#define PH_END(g) do { const unsigned long long t_ = __builtin_amdgcn_s_memrealtime(); if ((g) == PROBE_GROUP) pr_acc += t_ - pr_t0; pr_t0 = t_; } while (0)
#else
#define PH_END(g) do { } while (0)
#endif
    prep_phase(p, lds);
    grid.sync(); PH_END(7);
    rowwise_phase(p.x, p.ctx, nullptr, nullptr, nullptr, nullptr, nullptr, ng0, mod0, mod0 + 1024, H, MT);
    GSYNC(); PH_END(2);
    run_gemm(lds, H, WABI, MT, ABIN, 1024, PX, ABIN, 1, ws);
    GSYNC(); PH_END(1);
    retention_phase(p, lds, PX, Yf, Yb); PH_END(8);
    swa_phase(p, lds, PX, Y);
    GSYNC(); PH_END(4);
    combine_phase(Yf, Yb, PX, Y);
    GSYNC(); PH_END(5);
    run_gemm(lds, Y, WABO, MT, 1024, 1024, OX, 1024, 0, ws);
    GSYNC(); PH_END(1);
    rowwise_phase(p.x, p.ctx, p.out, CTXR, OX, ng0 + 1024, mod0 + 2 * 1024, ng0 + 2048, mod0 + 3 * 1024, mod0 + 4 * 1024, H, MT);
    GSYNC(); PH_END(2);
    run_gemm_conv(lds, H, WUP, MT, ACT, HALO, p.ffn_conv_w, p.ffn_conv_b);
    GSYNC(); PH_END(1);
    convfix_phase(HALO, ACT, p.ffn_conv_w, p.ffn_conv_b, MT / 64);
    GSYNC(); PH_END(3);
    run_gemm(lds, ACT, WDN, MT, 1024, DFF, OX, 1024, 0, ws);
    GSYNC(); PH_END(1);
    rowwise_phase(p.out, CTXR, p.out, CTXR, OX, ng0 + 3072, mod0 + 5 * 1024, ng1, mod1, mod1 + 1024, H, MT);
    GSYNC(); PH_END(2);
    run_gemm(lds, H, WNAI, ML, NA3, 1024, PX, NA3, 2, ws);
    run_gemm(lds, H + (size_t)ML * 1024, WNAI + (size_t)1024 * 1024, MC, 2048, 1024, PX + (size_t)ML * NA3 + 1024, NA3, 0, ws);
    GSYNC(); PH_END(1);
    na_phase(p, lds, PX, Y);
    GSYNC(); PH_END(6);
    run_gemm(lds, Y, WNAO, ML, 1024, 1024, OX, 1024, 0, ws);
    GSYNC(); PH_END(1);
    rowwise_phase(p.out, CTXR, p.out, CTXR, OX, ng1 + 1024, mod1 + 2 * 1024, ng1 + 2048, mod1 + 3 * 1024, mod1 + 4 * 1024, H, ML);
    GSYNC(); PH_END(2);
    run_gemm_conv(lds, H, WUP + (size_t)NUP * 1024, ML, ACT, HALO, p.ffn_conv_w + 3 * NUP, p.ffn_conv_b + NUP);
    GSYNC(); PH_END(1);
    convfix_phase(HALO, ACT, p.ffn_conv_w + 3 * NUP, p.ffn_conv_b + NUP, ML / 64);
    GSYNC(); PH_END(3);
    run_gemm(lds, ACT, WDN + (size_t)1024 * DFF, ML, 1024, DFF, OX, 1024, 0, ws);
    GSYNC(); PH_END(1);
    rowwise_phase(p.out, CTXR, p.out, CTXR, OX, ng1 + 3072, mod1 + 5 * 1024, nullptr, nullptr, nullptr, nullptr, ML);
    PH_END(2);
#ifdef PROBE_GROUP
    if (blockIdx.x == 0 && threadIdx.x == 0) { const unsigned long long te = __builtin_amdgcn_s_memrealtime(); while (__builtin_amdgcn_s_memrealtime() - te < 4ull * pr_acc) __builtin_amdgcn_s_sleep(20); }
#endif
}

extern "C" void kernel_launch(void* const* d_in, const int* in_sizes, int n_in, void* d_out, int out_size, void* d_ws, size_t ws_size, hipStream_t stream) {
    static int grid_blocks = 0;
    if (grid_blocks == 0) {
        if (n_in != 18 || ws_size < WS_END) { fprintf(stderr, "kernel_launch: unexpected n_in %d or ws_size %zu (need %zu)\n", n_in, ws_size, (size_t)WS_END); grid_blocks = -1; return; }
        int dev = 0, cus = 0, per_cu = 0;
        hipGetDevice(&dev);
        hipDeviceGetAttribute(&cus, hipDeviceAttributeMultiprocessorCount, dev);
        hipFuncSetAttribute((const void*)hybrid_fwd_megakernel, hipFuncAttributeMaxDynamicSharedMemorySize, LDS_BYTES);
        if (hipOccupancyMaxActiveBlocksPerMultiprocessor(&per_cu, (const void*)hybrid_fwd_megakernel, NTHREADS, LDS_BYTES) != hipSuccess || per_cu < 1) per_cu = 1;
        (void)hipGetLastError();
        grid_blocks = cus * per_cu;
    }
    if (grid_blocks < 0) return;
    Params p{};
    p.x = (const float*)d_in[0]; p.c = (const float*)d_in[1]; p.ctx = (const float*)d_in[2]; p.c_ctx = (const float*)d_in[3];
    p.w_mod = (const float*)d_in[4]; p.b_mod = (const float*)d_in[5]; p.norm_g = (const float*)d_in[6];
    p.ab_w_in = (const float*)d_in[7]; p.ab_w_out = (const float*)d_in[8]; p.ret_decay = (const float*)d_in[9]; p.swa_sink = (const float*)d_in[10];
    p.na_w_in = (const float*)d_in[11]; p.na_w_out = (const float*)d_in[12]; p.na_rpb = (const float*)d_in[13];
    p.ffn_w_up = (const float*)d_in[14]; p.ffn_conv_w = (const float*)d_in[15]; p.ffn_conv_b = (const float*)d_in[16]; p.ffn_w_down = (const float*)d_in[17];
    p.out = (float*)d_out; p.ws = (unsigned char*)d_ws;
    if (hipMemsetAsync((unsigned char*)d_ws + WS_BAR, 0, 16384, stream) != hipSuccess) { fprintf(stderr, "kernel_launch: memset of barrier words failed\n"); return; }
    void* args[] = {&p};
    hipError_t e = hipLaunchCooperativeKernel((const void*)hybrid_fwd_megakernel, dim3(grid_blocks), dim3(NTHREADS), args, LDS_BYTES, stream);
    if (e != hipSuccess) fprintf(stderr, "cooperative launch failed: %s (grid %d)\n", hipGetErrorString(e), grid_blocks);
}
```
